# Optimizing an MI355X kernel written in HIP

```python
import jax, jax.numpy as jnp
from jax import lax
import numpy as np

D_MODEL = 1024
BATCH = 16
SEQ = 4096
DEPTH = 4

GRID_W = 64
MIX_W = D_MODEL
ATTN_W = MIX_W // 2
CONV_W = MIX_W - ATTN_W
HEAD_DIM = 64
N_ATTN_HEADS = ATTN_W // HEAD_DIM
N_CONV_GROUPS = CONV_W // HEAD_DIM
WIN_H_MAX = 8
WIN_W = 16
CONV_K = 3
IN_COLS = 3 * ATTN_W + 3 * CONV_W
D_FF = ((8 * D_MODEL + 3 * 256 - 1) // (3 * 256)) * 256
PLE_DIM = 256
EPS = 1e-6

kernel_name = 'hybrid_natten_shortconv_encoder'


def rmsnorm(x, g):
    xf = x.astype(jnp.float32)
    y = xf * lax.rsqrt(jnp.mean(xf * xf, axis=-1, keepdims=True) + EPS)
    return (y * g.astype(jnp.float32)).astype(x.dtype)


def neighbourhood_attention(q, k, v, rpb):
    b, s, h, dh = q.shape
    rows = s // GRID_W
    kh = min(WIN_H_MAX, rows)
    qg = q.reshape(b, rows, GRID_W, h, dh)
    kg = k.reshape(b, rows, GRID_W, h, dh)
    vg = v.reshape(b, rows, GRID_W, h, dh)
    cols = jnp.arange(GRID_W)
    col_start = jnp.clip(cols - WIN_W // 2, 0, GRID_W - WIN_W)
    col_idx = col_start[:, None] + jnp.arange(WIN_W)[None, :]
    col_off = col_idx - cols[:, None] + (WIN_W - 1)
    rpb_cols = rpb[:, :, col_off]
    scale = dh ** -0.5

    def row_block(r):
        r0 = jnp.clip(r - kh // 2, 0, rows - kh)
        q_r = lax.dynamic_index_in_dim(qg, r, axis=1, keepdims=False)
        k_r = lax.dynamic_slice_in_dim(kg, r0, kh, axis=1)
        v_r = lax.dynamic_slice_in_dim(vg, r0, kh, axis=1)
        k_nb = k_r[:, :, col_idx]
        v_nb = v_r[:, :, col_idx]
        row_off = r0 + jnp.arange(kh) - r + (WIN_H_MAX - 1)
        bias = jnp.take(rpb_cols, row_off, axis=1).transpose(0, 2, 1, 3)
        sc = jnp.einsum('bqhd,bkqjhd->bhqkj', q_r, k_nb).astype(jnp.float32) * scale + bias[None].astype(jnp.float32)
        pr = jax.nn.softmax(sc.reshape(b, h, GRID_W, kh * WIN_W), axis=-1)
        pr = pr.reshape(b, h, GRID_W, kh, WIN_W).astype(v.dtype)
        return jnp.einsum('bhqkj,bkqjhd->bqhd', pr, v_nb)

    out = lax.map(row_block, jnp.arange(rows))
    return out.transpose(1, 0, 2, 3, 4).reshape(b, s, h * dh)


def centred_depthwise_conv(u, w):
    c = u.shape[-1]
    return lax.conv_general_dilated(
        u, w[:, None, :].astype(u.dtype), window_strides=(1,),
        padding=((CONV_K // 2, CONV_K // 2),),
        dimension_numbers=('NWC', 'WIO', 'NWC'), feature_group_count=c)


def setup_inputs(seed: int = 0) -> dict:
    key = jax.random.key(seed)
    ks = jax.random.split(key, 20)
    f32 = jnp.float32

    def nrm(k, shape, scale):
        return jax.random.normal(k, shape, f32) * scale

    def gain(k, shape):
        return 1.0 + 0.01 * jax.random.normal(k, shape, f32)

    return {
        'x': nrm(ks[0], (BATCH, SEQ, D_MODEL), 1.0),
        'p': nrm(ks[1], (DEPTH, BATCH, SEQ, PLE_DIM), 1.0),
        'g_mix': gain(ks[2], (DEPTH, D_MODEL)),
        'w_in': nrm(ks[3], (DEPTH, D_MODEL, IN_COLS), D_MODEL ** -0.5),
        'rpb': nrm(ks[4], (DEPTH, N_ATTN_HEADS, 2 * WIN_H_MAX - 1, 2 * WIN_W - 1), 0.02),
        'conv_w': nrm(ks[5], (DEPTH, CONV_K, CONV_W), CONV_K ** -0.5),
        'g_attn_out': gain(ks[6], (DEPTH, ATTN_W)),
        'g_conv_out': gain(ks[7], (DEPTH, CONV_W)),
        'w_out': nrm(ks[8], (DEPTH, MIX_W, D_MODEL), MIX_W ** -0.5),
        'g_ffn': gain(ks[9], (DEPTH, D_MODEL)),
        'w_gate': nrm(ks[10], (DEPTH, D_MODEL, D_FF), D_MODEL ** -0.5),
        'w_up': nrm(ks[11], (DEPTH, D_MODEL, D_FF), D_MODEL ** -0.5),
        'w_down': nrm(ks[12], (DEPTH, D_FF, D_MODEL), D_FF ** -0.5),
        'g_ple': gain(ks[13], (DEPTH, D_MODEL)),
        'w_ple_gate': nrm(ks[14], (DEPTH, D_MODEL, D_MODEL), D_MODEL ** -0.5),
        'w_ple_proj': nrm(ks[15], (DEPTH, PLE_DIM, D_MODEL), PLE_DIM ** -0.5),
        'g_final': gain(ks[16], (D_MODEL,)),
    }


def reference(x, p, g_mix, w_in, rpb, conv_w, g_attn_out, g_conv_out, w_out,
              g_ffn, w_gate, w_up, w_down, g_ple, w_ple_gate, w_ple_proj, g_final):
    b, s, _ = x.shape
    h = x
    for i in range(DEPTH):
        hn = rmsnorm(h, g_mix[i])
        z = hn @ w_in[i]
        q, k, v, cb, cc, cu = jnp.split(
            z, [ATTN_W, 2 * ATTN_W, 3 * ATTN_W, 3 * ATTN_W + CONV_W, 3 * ATTN_W + 2 * CONV_W], axis=-1)
        hd = (b, s, N_ATTN_HEADS, HEAD_DIM)
        attn = neighbourhood_attention(q.reshape(hd), k.reshape(hd), v.reshape(hd), rpb[i])
        conv = cb * centred_depthwise_conv(cc * cu, conv_w[i])
        mixed = jnp.concatenate([rmsnorm(attn, g_attn_out[i]), rmsnorm(conv, g_conv_out[i])], axis=-1)
        h = h + mixed @ w_out[i]
        hn = rmsnorm(h, g_ffn[i])
        h = h + (jax.nn.silu(hn @ w_gate[i]) * (hn @ w_up[i])) @ w_down[i]
        hn = rmsnorm(h, g_ple[i])
        h = h + jax.nn.sigmoid(hn @ w_ple_gate[i]) * (p[i] @ w_ple_proj[i])
    return rmsnorm(h, g_final)
```

```cpp
#include <hip/hip_runtime.h>
#include <hip/hip_cooperative_groups.h>
#include <cstdio>
#include <cstdint>
namespace cg = cooperative_groups;

namespace pg8 {
#define PG8_LAS __attribute__((address_space(3)))
typedef unsigned short bf16_t;
typedef short bf16x8 __attribute__((ext_vector_type(8)));
typedef float f32x4 __attribute__((ext_vector_type(4)));
typedef unsigned u32x4 __attribute__((ext_vector_type(4)));
constexpr int BM = 256, BK = 64, HALF = 128, HTB = HALF * BK * 2  , STAGE_BYTES = 8 * HTB, NXCD = 8, WGM = 8;

__host__ __device__ __forceinline__ int lds_byte(int r, int c) { const int st = (r >> 4) * 2 + (c >> 5), rr = r & 15, cc = c & 31, ob = rr * 64 + cc * 2; return st * 1024 + (ob ^ (((ob >> 9) & 1) << 5)); }
__host__ __device__ __forceinline__ void stage_rc(int b, int& R, int& C) { const int st = b / 1024, sb = b % 1024, swz = sb ^ (((sb >> 9) & 1) << 5); R = (st >> 1) * 16 + swz / 64; C = (st & 1) * 32 + (swz % 64) / 2; }
__host__ __device__ __forceinline__ int perm32(int rho) { const int n = rho >> 4, i = rho & 15; return 8 * (i >> 2) + 4 * n + (i & 3); }

struct Unit { int pm, pn; };
struct Gemm { const bf16_t* A; const bf16_t* Bt; int M, N, K, lda; };

struct StaticOrder {
    int nM, nN, nwg, G, c;
    __host__ __device__ void init(int M, int N, int G_, int c_) { nM = M / BM; nN = N / BM; nwg = nM * nN; G = G_; c = c_; }
    __host__ __device__ bool next(int i, Unit& u) const {
        const long L = (long)i * G + c; if (L >= nwg) return false;
        int wgid = (int)L; { const int q = nwg / NXCD, r = nwg % NXCD, xcd = wgid % NXCD, off = wgid / NXCD; wgid = (xcd < r ? xcd * (q + 1) : r * (q + 1) + (xcd - r) * q) + off; }
        const int nig = WGM * nN, gid = wgid / nig, fm = gid * WGM, gsz = (nM - fm) < WGM ? (nM - fm) : WGM;
        u.pm = fm + ((wgid % nig) % gsz); u.pn = (wgid % nig) / gsz; return true;
    }
    __device__ __forceinline__ void a_ready(const Unit&) const {}
    __device__ __forceinline__ void done(const Unit&) const {}
};
__device__ __forceinline__ unsigned cvt_pk_bf16(float lo, float hi) { unsigned r; asm volatile("v_cvt_pk_bf16_f32 %0, %1, %2" : "=v"(r) : "v"(lo), "v"(hi)); return r; }
template <class Epi, class Sched, bool ALIGN_EPI = false, bool SP2 = false>
__device__ __forceinline__ void gemm_phase(PG8_LAS unsigned char* lds, const Gemm g, const Sched& S, const Epi& E) {
    int tid_l = threadIdx.x; asm volatile("" : "+v"(tid_l));
    const int tid = tid_l, wid = __builtin_amdgcn_readfirstlane(tid >> 6), lane = tid & 63, wr = wid >> 2, wc = wid & 3, fr = lane & 15, fq = lane >> 4;
    int K_l = g.K; asm volatile("" : "+s"(K_l));
    const int K = K_l, nt = K / BK;
    int lda_l = g.lda; asm volatile("" : "+s"(lda_l)); const int lda = lda_l;
    unsigned voffA[2], voffB[2];
#pragma unroll
    for (int i = 0; i < 2; ++i) { int R, C; stage_rc(tid * 16 + i * 8192, R, C); const int Rb = Epi::PERM ? ((R & ~31) + perm32(R & 31)) : R;
        voffA[i] = (unsigned)(R * lda + C) * 2u; voffB[i] = (unsigned)(Rb * K + C) * 2u; }
    const size_t kstep = (size_t)(BK * 2);
    const size_t hstepA = (size_t)HALF * lda * 2, tstepA = 2 * hstepA;
    const size_t hstep = (size_t)HALF * K * 2;
    const size_t tstep = 2 * hstep;
    const unsigned ldsw = (unsigned)wid * 1024u;
    const int aoff = lds_byte(wr * 64 + fr, fq * 8), boff = lds_byte(wc * 32 + fr, fq * 8);
#define PG8_SA(b, h) (((b) * 2 + (h)) * HTB)
#define PG8_SB(b, h) ((4 + (b) * 2 + (h)) * HTB)
#define PG8_STAGE(bufoff, gbase, voff) do { _Pragma("unroll") for (int _i = 0; _i < 2; ++_i) \
        __builtin_amdgcn_global_load_lds((const unsigned*)((const char*)(gbase) + (voff)[_i]), (PG8_LAS unsigned*)(lds + (bufoff) + ldsw + _i * 8192), 16, 0, 0); } while (0)
#define PG8_LDA(dst, b, h) do { _Pragma("unroll") for (int m = 0; m < 4; ++m) _Pragma("unroll") for (int k = 0; k < 2; ++k) dst[m][k] = *(const PG8_LAS bf16x8*)(lds + PG8_SA(b, h) + aoff + m * 2048 + k * 1024); } while (0)
#define PG8_LDB(dst, b, h) do { _Pragma("unroll") for (int n = 0; n < 2; ++n) _Pragma("unroll") for (int k = 0; k < 2; ++k) dst[n][k] = *(const PG8_LAS bf16x8*)(lds + PG8_SB(b, h) + boff + n * 2048 + k * 1024); } while (0)
#define PG8_MMA(ai, bj, At, Bt) do { __builtin_amdgcn_s_setprio(1); _Pragma("unroll") for (int m = 0; m < 4; ++m) _Pragma("unroll") for (int n = 0; n < 2; ++n) _Pragma("unroll") for (int k = 0; k < 2; ++k) \
        acc[ai][bj][m][n] = __builtin_amdgcn_mfma_f32_16x16x32_bf16(Bt[n][k], At[m][k], acc[ai][bj][m][n], 0, 0, 0); __builtin_amdgcn_s_setprio(0); } while (0)
#define PG8_WAIT_V(n) asm volatile("s_waitcnt vmcnt(" #n ")" ::: "memory")
#define PG8_WAIT_SEL(d, w4, w8) do { if constexpr (Epi::SPLIT) { if (d) { if constexpr (Epi::NSH == 4) PG8_WAIT_V(w4); else PG8_WAIT_V(w8); } else PG8_WAIT_V(8); } else PG8_WAIT_V(8); } while (0)
#define PG8_WAIT_L(n) asm volatile("s_waitcnt lgkmcnt(" #n ")" ::: "memory")
#define PG8_BAR __builtin_amdgcn_s_barrier()
#define PG8_SCHED __builtin_amdgcn_sched_barrier(0)
    Unit cur, nxt, prev; int ui = 0; prev.pm = 0; prev.pn = 0;
    PG8_LAS float* const rv1 = (PG8_LAS float*)(lds + STAGE_BYTES) + tid * 4;
    if (!S.next(0, cur)) return;
    f32x4 acc[2][2][4][2];
#pragma unroll
    for (int a = 0; a < 2; ++a)
#pragma unroll
        for (int b = 0; b < 2; ++b)
#pragma unroll
            for (int m = 0; m < 4; ++m)
#pragma unroll
                for (int n = 0; n < 2; ++n) acc[a][b][m][n] = (f32x4){0.f, 0.f, 0.f, 0.f};
    bf16x8 At[4][2], B0[2][2], B1[2][2];
    const char* cA = (const char*)g.A + (size_t)cur.pm * tstepA; const char* cB = (const char*)g.Bt + (size_t)cur.pn * tstep;
    S.a_ready(cur);
    if constexpr (SP2) {
        PG8_STAGE(PG8_SB(0, 0), cB, voffB); PG8_STAGE(PG8_SB(0, 1), cB + hstep, voffB); PG8_STAGE(PG8_SA(0, 0), cA, voffA); PG8_STAGE(PG8_SA(0, 1), cA + hstepA, voffA);
        if (wr == 1) PG8_BAR;
        PG8_WAIT_V(2); PG8_BAR;
        PG8_STAGE(PG8_SB(1, 0), cB + kstep, voffB); PG8_STAGE(PG8_SA(1, 0), cA + kstep, voffA); PG8_STAGE(PG8_SB(1, 1), cB + hstep + kstep, voffB);
        PG8_WAIT_V(6); PG8_BAR;
    } else {
        PG8_STAGE(PG8_SB(0, 0), cB, voffB); PG8_STAGE(PG8_SA(0, 0), cA, voffA); PG8_STAGE(PG8_SB(0, 1), cB + hstep, voffB); PG8_STAGE(PG8_SA(0, 1), cA + hstepA, voffA);
        if (wr == 1) PG8_BAR;
        PG8_WAIT_V(4); PG8_BAR;
        PG8_STAGE(PG8_SB(1, 0), cB + kstep, voffB); PG8_STAGE(PG8_SA(1, 0), cA + kstep, voffA); PG8_STAGE(PG8_SB(1, 1), cB + hstep + kstep, voffB);
        PG8_WAIT_V(6); PG8_BAR;
    }
    for (;;) {
        const bool has_next = S.next(ui + 1, nxt);
        const char* nA = has_next ? (const char*)g.A + (size_t)nxt.pm * tstepA : cA; const char* nB = has_next ? (const char*)g.Bt + (size_t)nxt.pn * tstep : cB;
        for (int t = 0; t < nt; t += 2) {
            const bool last = (t == nt - 2);
            if constexpr (Epi::RVLDS) { if (last) {
                const char* pg = (const char*)E.part_in + (size_t)cur.pm * 16384 + (size_t)tid * 16;
                __builtin_amdgcn_global_load_lds((const unsigned*)pg, (PG8_LAS unsigned*)(lds + STAGE_BYTES + ldsw), 16, 0, 0);
                __builtin_amdgcn_global_load_lds((const unsigned*)(pg + 8192), (PG8_LAS unsigned*)(lds + STAGE_BYTES + 8192 + ldsw), 16, 0, 0); } }
            const bool plast = Epi::RVLDS && last;
            const bool defer = Epi::SPLIT && (t == 0) && (ui > 0);
            const char* a1 = cA + (size_t)(t + 1) * kstep;
            const char* a2 = last ? nA : cA + (size_t)(t + 2) * kstep; const char* b2 = last ? nB : cB + (size_t)(t + 2) * kstep;
            const char* a3 = a2 + kstep; const char* b3 = b2 + kstep;
            if (last && has_next) S.a_ready(nxt);
            if constexpr (SP2) {
            PG8_LDB(B0, 0, 0); PG8_LDB(B1, 0, 1); PG8_SCHED; PG8_LDA(At, 0, 0); PG8_STAGE(PG8_SA(1, 1), a1 + hstepA, voffA);
            if (plast) PG8_WAIT_V(10); else PG8_WAIT_SEL(defer, 12, 16);
            PG8_WAIT_L(0); PG8_BAR; PG8_MMA(0, 0, At, B0); PG8_MMA(0, 1, At, B1);
            if constexpr (Epi::SPLIT) { if (defer) {
                E.second(acc, prev, rv1, wr, wc, fr, fq);
                _Pragma("unroll") for (int b = 0; b < 2; ++b) _Pragma("unroll") for (int m = 0; m < 4; ++m) _Pragma("unroll") for (int n = 0; n < 2; ++n) acc[1][b][m][n] = (f32x4){0.f, 0.f, 0.f, 0.f}; } }
            PG8_BAR; PG8_SCHED;
            PG8_LDA(At, 0, 1); PG8_STAGE(PG8_SB(0, 0), b2, voffB); PG8_STAGE(PG8_SB(0, 1), b2 + hstep, voffB); PG8_STAGE(PG8_SA(0, 0), a2, voffA);
            if (plast) PG8_WAIT_V(10); else PG8_WAIT_SEL(defer, 16, 24);
            PG8_WAIT_L(0); PG8_BAR; PG8_MMA(1, 0, At, B0); PG8_MMA(1, 1, At, B1); PG8_BAR; PG8_SCHED;
            PG8_LDB(B0, 1, 0); PG8_LDB(B1, 1, 1); PG8_SCHED; PG8_LDA(At, 1, 0); PG8_STAGE(PG8_SA(0, 1), a2 + hstepA, voffA);
            PG8_WAIT_SEL(defer, 12, 16); PG8_WAIT_L(0); PG8_BAR; PG8_MMA(0, 0, At, B0); PG8_MMA(0, 1, At, B1); PG8_BAR; PG8_SCHED;
            PG8_LDA(At, 1, 1); PG8_STAGE(PG8_SB(1, 0), b3, voffB); PG8_STAGE(PG8_SB(1, 1), b3 + hstep, voffB); PG8_STAGE(PG8_SA(1, 0), a3, voffA);
            PG8_WAIT_V(8); PG8_WAIT_L(0); PG8_BAR; PG8_MMA(1, 0, At, B0); PG8_MMA(1, 1, At, B1); PG8_BAR; PG8_SCHED;
            } else {
            PG8_LDB(B0, 0, 0); PG8_SCHED; PG8_LDA(At, 0, 0); PG8_STAGE(PG8_SA(1, 1), a1 + hstepA, voffA);
            PG8_WAIT_L(8); PG8_BAR; PG8_WAIT_L(0); PG8_MMA(0, 0, At, B0); PG8_BAR; PG8_SCHED;
            PG8_LDB(B1, 0, 1); PG8_STAGE(PG8_SB(0, 0), b2, voffB);
            PG8_BAR; PG8_WAIT_L(0); PG8_MMA(0, 1, At, B1); PG8_BAR;
            PG8_LDA(At, 0, 1); PG8_STAGE(PG8_SA(0, 0), a2, voffA);
            PG8_BAR; PG8_WAIT_L(0); PG8_MMA(1, 0, At, B0); PG8_BAR; PG8_SCHED;
            PG8_STAGE(PG8_SB(0, 1), b2 + hstep, voffB);
            PG8_WAIT_V(6); PG8_BAR; PG8_MMA(1, 1, At, B1); PG8_BAR;
            PG8_LDB(B0, 1, 0); PG8_SCHED; PG8_LDA(At, 1, 0); PG8_STAGE(PG8_SA(0, 1), a2 + hstepA, voffA);
            PG8_WAIT_L(8); PG8_BAR; PG8_WAIT_L(0); PG8_MMA(0, 0, At, B0); PG8_BAR; PG8_SCHED;
            PG8_LDB(B1, 1, 1); PG8_STAGE(PG8_SB(1, 0), b3, voffB);
            PG8_BAR; PG8_WAIT_L(0); PG8_MMA(0, 1, At, B1); PG8_BAR;
            PG8_LDA(At, 1, 1); PG8_STAGE(PG8_SA(1, 0), a3, voffA);
            PG8_BAR; PG8_WAIT_L(0); PG8_MMA(1, 0, At, B0); PG8_BAR; PG8_SCHED;
            PG8_STAGE(PG8_SB(1, 1), b3 + hstep, voffB);
            PG8_WAIT_V(6); PG8_BAR; PG8_MMA(1, 1, At, B1); PG8_BAR;
            }
        }
        if constexpr (ALIGN_EPI) { if (wr == 0) PG8_BAR; }
        if constexpr (Epi::SPLIT) {
            if (has_next) { E.first(acc, cur, rv1, wr, wc, fr, fq); prev = cur; }
            else E(acc, cur, wr, wc, fr, fq, lds + STAGE_BYTES);
        } else if constexpr (!Epi::AFTER_DRAIN) { E(acc, cur, wr, wc, fr, fq, lds + STAGE_BYTES); S.done(cur); }
        if (!has_next) break;
#pragma unroll
        for (int a = 0; a < (Epi::SPLIT ? 1 : 2); ++a)
#pragma unroll
            for (int b = 0; b < 2; ++b)
#pragma unroll
                for (int m = 0; m < 4; ++m)
#pragma unroll
                    for (int n = 0; n < 2; ++n) acc[a][b][m][n] = (f32x4){0.f, 0.f, 0.f, 0.f};
        cur = nxt; cA = nA; cB = nB; ++ui;
        if constexpr (ALIGN_EPI) { if (wr == 1) PG8_BAR; }
    }
    PG8_WAIT_V(0);
    if constexpr (!ALIGN_EPI) { if (wr == 0) PG8_BAR; }
    PG8_BAR;
    if constexpr (Epi::AFTER_DRAIN) { E.fused(acc, cur, wr, wc, fr, fq, lds, wid, lane); S.done(cur); }
#undef PG8_SA
#undef PG8_SB
#undef PG8_STAGE
#undef PG8_LDA
#undef PG8_LDB
#undef PG8_MMA
#undef PG8_WAIT_V
#undef PG8_WAIT_SEL
#undef PG8_WAIT_L
#undef PG8_BAR
#undef PG8_SCHED
}
}

using pg8::bf16_t; using pg8::f32x4; using pg8::u32x4; using pg8::bf16x8;
#define LAS __attribute__((address_space(3)))
constexpr int DM = 1024, MTOK = 65536, SEQ = 4096, NIN = 3072, DFF = 2816, NGU = 2 * DFF, PLE = 256, DEPTH = 4;
constexpr float EPS = 1e-6f;
constexpr size_t MiB = 1u << 20;
constexpr size_t WS_PART0 = 0, WS_PART1 = 4 * MiB;
constexpr size_t WS_W = 8 * MiB, W_LAYER = 27 * MiB;
constexpr size_t WO_IN = 0, WO_OUT = 6 * MiB, WO_GU = 8 * MiB, WO_DOWN = 19 * MiB, WO_PG = 24 * MiB + MiB / 2, WO_PP = 26 * MiB + MiB / 2;
constexpr size_t WS_HB = 128 * MiB;
constexpr size_t WS_Z = 256 * MiB;
constexpr size_t WS_MIX = 640 * MiB;
constexpr size_t WS_PB = 768 * MiB;
constexpr size_t WS_BAR = 120 * MiB;
constexpr size_t WS_HB1 = 896 * MiB;
constexpr size_t WS_END = 1024 * MiB;
constexpr int LDS_BYTES = 163840;

__device__ __forceinline__ float bf_lo(unsigned w) { return __uint_as_float(w << 16); }
__device__ __forceinline__ float bf_hi(unsigned w) { return __uint_as_float(w & 0xffff0000u); }
__device__ __forceinline__ float fast_sigmoid(float x) { return __builtin_amdgcn_rcpf(1.0f + __expf(-x)); }

__device__ __forceinline__ float xrow16_max(float x) {
    auto s = __builtin_amdgcn_permlane16_swap(__float_as_uint(x), __float_as_uint(x), false, false);
    x = fmaxf(__uint_as_float(s[0]), __uint_as_float(s[1]));
    auto t = __builtin_amdgcn_permlane32_swap(__float_as_uint(x), __float_as_uint(x), false, false);
    return fmaxf(__uint_as_float(t[0]), __uint_as_float(t[1]));
}
__device__ __forceinline__ float xrow16_sum(float x) {
    auto s = __builtin_amdgcn_permlane16_swap(__float_as_uint(x), __float_as_uint(x), false, false);
    x = __uint_as_float(s[0]) + __uint_as_float(s[1]);
    auto t = __builtin_amdgcn_permlane32_swap(__float_as_uint(x), __float_as_uint(x), false, false);
    return __uint_as_float(t[0]) + __uint_as_float(t[1]);
}
__device__ __forceinline__ float row_rinv(const float* part, int row) {
    const f32x4* p = (const f32x4*)(part + (size_t)row * 16);
    const f32x4 s = (p[0] + p[1]) + (p[2] + p[3]);
    return __builtin_amdgcn_rsqf(((s[0] + s[1]) + (s[2] + s[3])) * (1.0f / 1024.0f) + EPS);
}

template <int MODE> struct Epi {
    static constexpr bool PERM = true, AFTER_DRAIN = false;
    static constexpr bool SPLIT = false;
    static constexpr bool RVLDS = (MODE == 0 || MODE == 1 || MODE == 4);
    static constexpr int NSH = (MODE == 1) ? 4 : 8;
    bf16_t* O; int ldc; const float* part_in; const bf16_t* h_old; float* part_out; const bf16_t* pp;
    template <int AI> __device__ __forceinline__ void store_half(const f32x4 (&acc)[2][2][4][2], const pg8::Unit& u, const float (&rvh)[4], int wr, int wc, int fr, int fq) const {
        const int row0 = u.pm * 256 + wr * 64 + fr;
#pragma unroll
        for (int m = 0; m < 4; ++m) {
            const int row = row0 + AI * 128 + m * 16;
            const float rinv = (MODE == 2) ? 1.f : rvh[m];
            if (MODE == 0 || MODE == 2) {
                bf16_t* rowp = O + (size_t)row * ldc + u.pn * 256 + wc * 32 + 8 * fq;
#pragma unroll
                for (int bj = 0; bj < 2; ++bj) { const f32x4 v0 = acc[AI][bj][m][0] * rinv, v1 = acc[AI][bj][m][1] * rinv;
                    u32x4 w; w.x = pg8::cvt_pk_bf16(v0[0], v0[1]); w.y = pg8::cvt_pk_bf16(v0[2], v0[3]); w.z = pg8::cvt_pk_bf16(v1[0], v1[1]); w.w = pg8::cvt_pk_bf16(v1[2], v1[3]);
                    *(u32x4*)(rowp + bj * 128) = w; }
            } else {
                bf16_t* rowp = O + (size_t)row * ldc + u.pn * 128 + wc * 32 + 8 * fq;
                float a[8];
#pragma unroll
                for (int n = 0; n < 2; ++n)
#pragma unroll
                    for (int j = 0; j < 4; ++j) { const float g = acc[AI][0][m][n][j] * rinv, up = acc[AI][1][m][n][j] * rinv; a[4 * n + j] = g * fast_sigmoid(g) * up; }
                u32x4 w; w.x = pg8::cvt_pk_bf16(a[0], a[1]); w.y = pg8::cvt_pk_bf16(a[2], a[3]); w.z = pg8::cvt_pk_bf16(a[4], a[5]); w.w = pg8::cvt_pk_bf16(a[6], a[7]);
                *(u32x4*)rowp = w;
            }
            asm volatile("" ::: "memory");
        }
    }
    __device__ __forceinline__ void first(const f32x4 (&acc)[2][2][4][2], const pg8::Unit& u, LAS float* rv1p, int wr, int wc, int fr_, int fq_) const {
        int fr = fr_, fq = fq_; asm volatile("" : "+v"(fr), "+v"(fq));
        const int row0 = u.pm * 256 + wr * 64 + fr;
        float rv0[4] = {1.f, 1.f, 1.f, 1.f}, rv1[4] = {1.f, 1.f, 1.f, 1.f};
        if (MODE != 2) {
            float t[2][4];
#pragma unroll
            for (int ai = 0; ai < 2; ++ai)
#pragma unroll
                for (int m = 0; m < 4; ++m) { const f32x4 pv = *((const f32x4*)(part_in + (size_t)(row0 + ai * 128 + m * 16) * 16) + fq); t[ai][m] = (pv[0] + pv[1]) + (pv[2] + pv[3]); }
#pragma unroll
            for (int m = 0; m < 4; ++m) { rv0[m] = __builtin_amdgcn_rsqf(xrow16_sum(t[0][m]) * (1.0f / 1024.0f) + EPS); rv1[m] = __builtin_amdgcn_rsqf(xrow16_sum(t[1][m]) * (1.0f / 1024.0f) + EPS); }
        }
        if (MODE != 2) *(LAS f32x4*)rv1p = (f32x4){rv1[0], rv1[1], rv1[2], rv1[3]};
        store_half<0>(acc, u, rv0, wr, wc, fr, fq);
    }
    __device__ __forceinline__ void second(const f32x4 (&acc)[2][2][4][2], const pg8::Unit& u, LAS const float* rv1p, int wr, int wc, int fr_, int fq_) const {
        int fr = fr_, fq = fq_; asm volatile("" : "+v"(fr), "+v"(fq));
        float rv1[4] = {1.f, 1.f, 1.f, 1.f};
        if (MODE != 2) { const f32x4 t = *(LAS const f32x4*)rv1p; rv1[0] = t[0]; rv1[1] = t[1]; rv1[2] = t[2]; rv1[3] = t[3]; }
        store_half<1>(acc, u, rv1, wr, wc, fr, fq);
    }
    __device__ __forceinline__ void operator()(const f32x4 (&acc)[2][2][4][2], const pg8::Unit& u, int wr, int wc, int fr_, int fq_, LAS const unsigned char* xl) const {
        int fr = fr_, fq = fq_; asm volatile("" : "+v"(fr), "+v"(fq));
        const int row0 = u.pm * 256 + wr * 64 + fr;
        float rv[2][4];
        if (MODE == 0 || MODE == 1 || MODE == 4) {
#pragma unroll
            for (int ai = 0; ai < 2; ++ai)
#pragma unroll
                for (int m = 0; m < 4; ++m) { const f32x4 pv = *(LAS const f32x4*)(xl + (ai * 128 + wr * 64 + m * 16 + fr) * 64 + fq * 16); rv[ai][m] = (pv[0] + pv[1]) + (pv[2] + pv[3]); }
#pragma unroll
            for (int ai = 0; ai < 2; ++ai)
#pragma unroll
                for (int m = 0; m < 4; ++m) rv[ai][m] = __builtin_amdgcn_rsqf(xrow16_sum(rv[ai][m]) * (1.0f / 1024.0f) + EPS);
        }
        if (MODE == 0 || MODE == 1 || MODE == 2) {
#pragma unroll
            for (int ai = 0; ai < 2; ++ai)
#pragma unroll
                for (int m = 0; m < 4; ++m) {
                    const int row = row0 + ai * 128 + m * 16;
                    const float rinv = (MODE == 2) ? 1.f : rv[ai][m];
                    if (MODE == 0 || MODE == 2) {
                        bf16_t* rowp = O + (size_t)row * ldc + u.pn * 256 + wc * 32 + 8 * fq;
#pragma unroll
                        for (int bj = 0; bj < 2; ++bj) { const f32x4 v0 = acc[ai][bj][m][0] * rinv, v1 = acc[ai][bj][m][1] * rinv;
                            u32x4 w; w.x = pg8::cvt_pk_bf16(v0[0], v0[1]); w.y = pg8::cvt_pk_bf16(v0[2], v0[3]); w.z = pg8::cvt_pk_bf16(v1[0], v1[1]); w.w = pg8::cvt_pk_bf16(v1[2], v1[3]);
                            *(u32x4*)(rowp + bj * 128) = w; }
                    } else {
                        bf16_t* rowp = O + (size_t)row * ldc + u.pn * 128 + wc * 32 + 8 * fq;
                        float a[8];
#pragma unroll
                        for (int n = 0; n < 2; ++n)
#pragma unroll
                            for (int j = 0; j < 4; ++j) { const float g = acc[ai][0][m][n][j] * rinv, up = acc[ai][1][m][n][j] * rinv; a[4 * n + j] = g * fast_sigmoid(g) * up; }
                        u32x4 w; w.x = pg8::cvt_pk_bf16(a[0], a[1]); w.y = pg8::cvt_pk_bf16(a[2], a[3]); w.z = pg8::cvt_pk_bf16(a[4], a[5]); w.w = pg8::cvt_pk_bf16(a[6], a[7]);
                        *(u32x4*)rowp = w;
                    }
                }
        } else {
            const int col = u.pn * 256 + wc * 32 + 8 * fq;
            constexpr int MB = (MODE == 4) ? 2 : 4;
#pragma unroll
            for (int ai = 0; ai < 2; ++ai)
#pragma unroll
            for (int mb = 0; mb < 4; mb += MB) {
                u32x4 hw[MB][2], pw[MB][2];
#pragma unroll
                for (int m = 0; m < MB; ++m)
#pragma unroll
                    for (int bj = 0; bj < 2; ++bj) { const size_t off = (size_t)(row0 + ai * 128 + (mb + m) * 16) * DM + col + bj * 128;
                        hw[m][bj] = *(const u32x4*)(h_old + off); if (MODE == 4) pw[m][bj] = *(const u32x4*)(pp + off); }
#pragma unroll
                for (int mm = 0; mm < MB; ++mm) {
                    const int m = mb + mm;
                    const int row = row0 + ai * 128 + m * 16; const float rinv = rv[ai][m];
                    float ss = 0.f;
#pragma unroll
                    for (int bj = 0; bj < 2; ++bj) { const size_t off = (size_t)row * DM + col + bj * 128;
                        const u32x4 h4 = hw[mm][bj];
                        f32x4 a = {bf_lo(h4.x), bf_hi(h4.x), bf_lo(h4.y), bf_hi(h4.y)}, b = {bf_lo(h4.z), bf_hi(h4.z), bf_lo(h4.w), bf_hi(h4.w)};
                        f32x4 d0 = acc[ai][bj][m][0], d1 = acc[ai][bj][m][1];
                        if (MODE == 4) { const u32x4 p4 = pw[mm][bj];
                            d0[0] = fast_sigmoid(d0[0] * rinv) * bf_lo(p4.x); d0[1] = fast_sigmoid(d0[1] * rinv) * bf_hi(p4.x);
                            d0[2] = fast_sigmoid(d0[2] * rinv) * bf_lo(p4.y); d0[3] = fast_sigmoid(d0[3] * rinv) * bf_hi(p4.y);
                            d1[0] = fast_sigmoid(d1[0] * rinv) * bf_lo(p4.z); d1[1] = fast_sigmoid(d1[1] * rinv) * bf_hi(p4.z);
                            d1[2] = fast_sigmoid(d1[2] * rinv) * bf_lo(p4.w); d1[3] = fast_sigmoid(d1[3] * rinv) * bf_hi(p4.w); }
                        a += d0; b += d1;
                        u32x4 w; w.x = pg8::cvt_pk_bf16(a[0], a[1]); w.y = pg8::cvt_pk_bf16(a[2], a[3]); w.z = pg8::cvt_pk_bf16(b[0], b[1]); w.w = pg8::cvt_pk_bf16(b[2], b[3]);
                        *(u32x4*)(O + off) = w;
                        ss += (a[0] * a[0] + a[1] * a[1]) + (a[2] * a[2] + a[3] * a[3]) + (b[0] * b[0] + b[1] * b[1]) + (b[2] * b[2] + b[3] * b[3]); }
                    ss = xrow16_sum(ss);
                    if (fq == 0) part_out[(size_t)row * 16 + u.pn * 4 + wc] = ss;
                }
            }
        }
    }
};

struct Args { const float* in[17]; float* out; unsigned char* ws; };
enum { I_X = 0, I_P, I_GMIX, I_WIN, I_RPB, I_CONVW, I_GATT, I_GCONV, I_WOUT, I_GFFN, I_WGATE, I_WUP, I_WDOWN, I_GPLE, I_WPG, I_WPP, I_GFINAL };

__device__ __forceinline__ float wave_sum(float v) {
#pragma unroll
    for (int o = 1; o < 64; o <<= 1) v += __shfl_xor(v, o);
    return v;
}
__device__ __forceinline__ void transpose_item(const float* W, int K, int N, bf16_t* WT, int mapmode, const float* ga, const float* gb, int ksplit, int qcols, LAS float* scr, int item, int lane) {
    const int nblk = N / 64, kb = item / nblk, nb = item % nblk, k0 = 64 * kb, n0 = 64 * nb;
    const float cs = (n0 < qcols) ? 0.125f * 1.44269504088896f : 1.0f;
    const int kl = lane >> 4, n4 = (lane & 15) * 4;
    f32x4 v[16];
#pragma unroll
    for (int i = 0; i < 16; ++i) v[i] = *(const f32x4*)(W + (size_t)(k0 + 4 * i + kl) * N + n0 + n4);
#pragma unroll
    for (int i = 0; i < 16; ++i) { const int kk = 4 * i + kl, k = k0 + kk;
        float g = cs; if (ga) g *= (k < ksplit) ? ga[k] : gb[k - ksplit];
        LAS float* d = scr + kk * 65 + n4; d[0] = v[i][0] * g; d[1] = v[i][1] * g; d[2] = v[i][2] * g; d[3] = v[i][3] * g; }
    asm volatile("s_waitcnt lgkmcnt(0)" ::: "memory");
    const int c = lane & 7;
    const int rbase = (mapmode == 0) ? n0 : (256 * (n0 >> 7) + (n0 & 127) + (mapmode == 2 ? 128 : 0));
#pragma unroll
    for (int j = 0; j < 8; ++j) { const int n = (lane >> 3) + 8 * j; const LAS float* sp = scr + (8 * c) * 65 + n;
        u32x4 o; o.x = pg8::cvt_pk_bf16(sp[0 * 65], sp[1 * 65]); o.y = pg8::cvt_pk_bf16(sp[2 * 65], sp[3 * 65]); o.z = pg8::cvt_pk_bf16(sp[4 * 65], sp[5 * 65]); o.w = pg8::cvt_pk_bf16(sp[6 * 65], sp[7 * 65]);
        *(u32x4*)(WT + (size_t)(rbase + n) * K + k0 + 8 * c) = o; }
    asm volatile("s_waitcnt lgkmcnt(0)" ::: "memory");
}

__device__ __forceinline__ void prologue(const Args& A, LAS unsigned char* lds) {
    int tid_l = threadIdx.x; asm volatile("" : "+v"(tid_l));
    const int tid = tid_l, lane = tid & 63, wave = tid >> 6;
    LAS float* scr = (LAS float*)(lds + wave * 19712);
    const int gw = blockIdx.x * 8 + wave, NGW = gridDim.x * 8;
    constexpr int I_IN = 16 * 48, I_OUT = 16 * 16, I_G = 16 * 44, I_DN = 44 * 16, I_PG = 16 * 16, I_PPI = 4 * 16;
    constexpr int PER_L = I_IN + I_OUT + 2 * I_G + I_DN + I_PG + I_PPI;
    for (int it = gw; it < DEPTH * PER_L; it += NGW) {
        const int L = it / PER_L; int r = it % PER_L;
        unsigned char* wl = A.ws + WS_W + (size_t)L * W_LAYER;
        if (r < I_IN) { transpose_item(A.in[I_WIN] + (size_t)L * DM * NIN, DM, NIN, (bf16_t*)(wl + WO_IN), 0, A.in[I_GMIX] + L * DM, A.in[I_GMIX] + L * DM, DM, 512, scr, r, lane); continue; } r -= I_IN;
        if (r < I_OUT) { transpose_item(A.in[I_WOUT] + (size_t)L * DM * DM, DM, DM, (bf16_t*)(wl + WO_OUT), 0, A.in[I_GATT] + L * 512, A.in[I_GCONV] + L * 512, 512, 0, scr, r, lane); continue; } r -= I_OUT;
        if (r < I_G) { transpose_item(A.in[I_WGATE] + (size_t)L * DM * DFF, DM, DFF, (bf16_t*)(wl + WO_GU), 1, A.in[I_GFFN] + L * DM, A.in[I_GFFN] + L * DM, DM, 0, scr, r, lane); continue; } r -= I_G;
        if (r < I_G) { transpose_item(A.in[I_WUP] + (size_t)L * DM * DFF, DM, DFF, (bf16_t*)(wl + WO_GU), 2, A.in[I_GFFN] + L * DM, A.in[I_GFFN] + L * DM, DM, 0, scr, r, lane); continue; } r -= I_G;
        if (r < I_DN) { transpose_item(A.in[I_WDOWN] + (size_t)L * DFF * DM, DFF, DM, (bf16_t*)(wl + WO_DOWN), 0, nullptr, nullptr, 0, 0, scr, r, lane); continue; } r -= I_DN;
        if (r < I_PG) { transpose_item(A.in[I_WPG] + (size_t)L * DM * DM, DM, DM, (bf16_t*)(wl + WO_PG), 0, A.in[I_GPLE] + L * DM, A.in[I_GPLE] + L * DM, DM, 0, scr, r, lane); continue; } r -= I_PG;
        transpose_item(A.in[I_WPP] + (size_t)L * PLE * DM, PLE, DM, (bf16_t*)(wl + WO_PP), 0, nullptr, nullptr, 0, 0, scr, r, lane);
    }
    const float* x = A.in[I_X]; bf16_t* hb = (bf16_t*)(A.ws + WS_HB); float* part = (float*)(A.ws + WS_PART0);
    for (int m = gw; m < MTOK; m += 2 * NGW) {
        const int m2 = m + NGW; const bool has2 = m2 < MTOK;
        const f32x4* xr = (const f32x4*)(x + (size_t)m * DM) + lane; const f32x4* xr2 = (const f32x4*)(x + (size_t)(has2 ? m2 : m) * DM) + lane;
        f32x4 v[4], w[4];
#pragma unroll
        for (int j = 0; j < 4; ++j) { v[j] = xr[64 * j]; w[j] = xr2[64 * j]; }
        float s = 0.f, s2 = 0.f;
        unsigned long long* o8 = (unsigned long long*)(hb + (size_t)m * DM) + lane; unsigned long long* o82 = (unsigned long long*)(hb + (size_t)(has2 ? m2 : m) * DM) + lane;
#pragma unroll
        for (int j = 0; j < 4; ++j) { s += (v[j][0] * v[j][0] + v[j][1] * v[j][1]) + (v[j][2] * v[j][2] + v[j][3] * v[j][3]); s2 += (w[j][0] * w[j][0] + w[j][1] * w[j][1]) + (w[j][2] * w[j][2] + w[j][3] * w[j][3]);
            o8[64 * j] = (unsigned long long)pg8::cvt_pk_bf16(v[j][0], v[j][1]) | ((unsigned long long)pg8::cvt_pk_bf16(v[j][2], v[j][3]) << 32);
            if (has2) o82[64 * j] = (unsigned long long)pg8::cvt_pk_bf16(w[j][0], w[j][1]) | ((unsigned long long)pg8::cvt_pk_bf16(w[j][2], w[j][3]) << 32); }
#pragma unroll
        for (int o = 1; o < 64; o <<= 1) { s += __shfl_xor(s, o); s2 += __shfl_xor(s2, o); }
        if (lane < 16) { part[(size_t)m * 16 + lane] = (lane == 0) ? s : 0.f; if (has2) part[(size_t)m2 * 16 + lane] = (lane == 0) ? s2 : 0.f; }
    }
    const float* p = A.in[I_P]; bf16_t* pb = (bf16_t*)(A.ws + WS_PB);
    const size_t n8 = (size_t)DEPTH * MTOK * PLE / 8, stride = (size_t)gridDim.x * 512;
    for (size_t i = (size_t)blockIdx.x * 512 + tid; i < n8; i += stride) {
        const f32x4 a = *(const f32x4*)(p + i * 8), b = *(const f32x4*)(p + i * 8 + 4);
        u32x4 w; w.x = pg8::cvt_pk_bf16(a[0], a[1]); w.y = pg8::cvt_pk_bf16(a[2], a[3]); w.z = pg8::cvt_pk_bf16(b[0], b[1]); w.w = pg8::cvt_pk_bf16(b[2], b[3]);
        *(u32x4*)(pb + i * 8) = w;
    }
}

__device__ __forceinline__ void unpack8(const u32x4 w, float* f) { f[0] = bf_lo(w.x); f[1] = bf_hi(w.x); f[2] = bf_lo(w.y); f[3] = bf_hi(w.y); f[4] = bf_lo(w.z); f[5] = bf_hi(w.z); f[6] = bf_lo(w.w); f[7] = bf_hi(w.w); }
typedef short v4i16_t __attribute__((ext_vector_type(4)));
constexpr int VS = 144;
constexpr int WREG = 19712;
constexpr int BT_OFF = 9216 + 256, Q_OFF = BT_OFF + 2048;
static_assert(8 * WREG + 2048 <= 163840, "mixer LDS map");
constexpr int SSBUF_OFF = 8 * WREG;
__device__ __forceinline__ v4i16_t vtr(LAS unsigned char* p) { return __builtin_amdgcn_ds_read_tr16_b64_v4i16((LAS v4i16_t*)p); }
__device__ __forceinline__ bf16x8 cat8(v4i16_t a, v4i16_t b) { bf16x8 r; r[0] = a[0]; r[1] = a[1]; r[2] = a[2]; r[3] = a[3]; r[4] = b[0]; r[5] = b[1]; r[6] = b[2]; r[7] = b[3]; return r; }
__device__ __forceinline__ bf16x8 packp(const f32x4 a, const f32x4 b) { u32x4 w; w.x = pg8::cvt_pk_bf16(a[0], a[1]); w.y = pg8::cvt_pk_bf16(a[2], a[3]); w.z = pg8::cvt_pk_bf16(b[0], b[1]); w.w = pg8::cvt_pk_bf16(b[2], b[3]); return __builtin_bit_cast(bf16x8, w); }

template <int JQ> struct QTiles { static constexpr int T0 = (JQ == 0) ? 0 : (JQ == 1) ? 0 : (JQ == 2) ? 1 : 2, T1 = (JQ == 0) ? 1 : (JQ == 1) ? 2 : 3, NT = T1 - T0 + 1; };
template <int JQ> __device__ __forceinline__ void qk(const bf16x8 (&kf)[4][2], LAS const unsigned char* qlds, LAS const float* brow, f32x4 (&s)[3], float (&bb)[3][4]) {
    constexpr int T0 = QTiles<JQ>::T0, NT = QTiles<JQ>::NT;
    const bf16x8 qf[2] = {*(LAS const bf16x8*)(qlds + (2 * JQ) * 1024), *(LAS const bf16x8*)(qlds + (2 * JQ + 1) * 1024)};
#pragma unroll
    for (int t = 0; t < NT; ++t)
#pragma unroll
        for (int e = 0; e < 4; ++e) bb[t][e] = brow[16 * (T0 + t - JQ + 1) + e];
#pragma unroll
    for (int t = 0; t < NT; ++t) {
        f32x4 a = {0.f, 0.f, 0.f, 0.f};
        a = __builtin_amdgcn_mfma_f32_16x16x32_bf16(kf[T0 + t][0], qf[0], a, 0, 0, 0);
        a = __builtin_amdgcn_mfma_f32_16x16x32_bf16(kf[T0 + t][1], qf[1], a, 0, 0, 0);
        s[t] = a;
    }
}
template <int JQ> __device__ __forceinline__ void sm(f32x4 (&s)[3], float (&bb)[3][4], int m0, float& mrun, float& lrun, f32x4 (&o)[4], bf16x8& pA, bf16x8& pB) {
    constexpr int T0 = QTiles<JQ>::T0, NT = QTiles<JQ>::NT;
    const float NEG = -__builtin_inff();
    if (NT == 2) asm volatile("" : "+v"(bb[0][0]), "+v"(bb[0][1]), "+v"(bb[0][2]), "+v"(bb[0][3]), "+v"(bb[1][0]), "+v"(bb[1][1]), "+v"(bb[1][2]), "+v"(bb[1][3]));
    else asm volatile("" : "+v"(bb[0][0]), "+v"(bb[0][1]), "+v"(bb[0][2]), "+v"(bb[0][3]), "+v"(bb[1][0]), "+v"(bb[1][1]), "+v"(bb[1][2]), "+v"(bb[1][3]), "+v"(bb[2][0]), "+v"(bb[2][1]), "+v"(bb[2][2]), "+v"(bb[2][3]));
    float mx = NEG;
#pragma unroll
    for (int t = 0; t < NT; ++t)
#pragma unroll
        for (int e = 0; e < 4; ++e) { const bool valid = (unsigned)(m0 + 16 * (T0 + t) + e) < 16u; const float v = s[t][e] + bb[t][e]; s[t][e] = valid ? v : NEG; mx = fmaxf(mx, s[t][e]); }
    mx = xrow16_max(mx);
    const float mnew = fmaxf(mrun, mx), alpha = __builtin_amdgcn_exp2f(mrun - mnew);
    mrun = mnew;
    float ps = 0.f;
#pragma unroll
    for (int t = 0; t < NT; ++t)
#pragma unroll
        for (int e = 0; e < 4; ++e) { const float p = __builtin_amdgcn_exp2f(s[t][e] - mnew); s[t][e] = p; ps += p; }
    lrun = lrun * alpha + ps;
#pragma unroll
    for (int dt = 0; dt < 4; ++dt) o[dt] *= alpha;
    const f32x4 zz = {0.f, 0.f, 0.f, 0.f};
    if (JQ == 0) { pA = packp(s[0], s[1]); }
    else if (JQ == 1) { pA = packp(s[0], s[1]); pB = packp(s[2], zz); }
    else if (JQ == 2) { pA = packp(zz, s[0]); pB = packp(s[1], s[2]); }
    else { pB = packp(s[0], s[1]); }
}

__device__ __forceinline__ void mixer_attn(const bf16_t* Z, bf16_t* MIX, int b, int r, LAS unsigned char* lds) {
    int tid_l = threadIdx.x; asm volatile("" : "+v"(tid_l));
    const int tid = tid_l, lane = tid & 63, h = __builtin_amdgcn_readfirstlane(tid >> 6), i = lane & 15, g = lane >> 4;
    LAS unsigned char* wl = lds + h * WREG;
    LAS const float* btab = (LAS const float*)(wl + BT_OFF);
    LAS float* ssbuf = (LAS float*)(lds + SSBUF_OFF);
    const bf16_t* zq = Z + ((size_t)b * SEQ + r * 64) * NIN + h * 64;
    LAS unsigned char* qlds = wl + Q_OFF + lane * 16;
#pragma unroll
    for (int jq = 0; jq < 4; ++jq)
#pragma unroll
        for (int dh = 0; dh < 2; ++dh) *(LAS bf16x8*)(qlds + (2 * jq + dh) * 1024) = *(const bf16x8*)((const char*)zq + (size_t)(((16 * jq) * NIN + 32 * dh) * 2) + (unsigned)(i * NIN + 8 * g) * 2u);
    f32x4 o[4][4]; float mrun[4], lrun[4]; int m0[4];
#pragma unroll
    for (int jq = 0; jq < 4; ++jq) { mrun[jq] = -__builtin_inff(); lrun[jq] = 0.f; m0[jq] = 4 * g - min(max(16 * jq + i - 8, 0), 48);
#pragma unroll
        for (int dt = 0; dt < 4; ++dt) o[jq][dt] = (f32x4){0.f, 0.f, 0.f, 0.f}; }
    const int r0 = min(max(r - 4, 0), 56), c0 = 4 * g - i;
    LAS unsigned char* vrd = wl + (4 * g + (i >> 2)) * VS + 8 * (i & 3);
    const bf16_t* kbb = Z + ((size_t)b * SEQ) * NIN + h * 64;
    const bf16_t* kb0 = kbb + (size_t)((r0 + ((0 - r0) & 7)) * 64) * NIN;
    const unsigned kfo = (unsigned)(i * NIN + 8 * g) * 2u;
    const unsigned vfo = (unsigned)((lane >> 3) * NIN + 8 * (lane & 7)) * 2u;
#define LDK(rowp, kt, dh) (*(const bf16x8*)((const char*)(rowp) + (size_t)(((16 * (kt)) * NIN + 512 + 32 * (dh)) * 2) + kfo))
#define LDV(rowp, n) (*(const u32x4*)((const char*)(rowp) + (size_t)(((8 * (n)) * NIN + 1024) * 2) + vfo))
    bf16x8 kf[4][2]; u32x4 vc[8];
#pragma unroll
    for (int n = 0; n < 8; ++n) vc[n] = LDV(kb0, n);
    asm volatile("" ::: "memory");
#pragma unroll
    for (int kt = 0; kt < 4; ++kt)
#pragma unroll
        for (int dh = 0; dh < 2; ++dh) kf[kt][dh] = LDK(kb0, kt, dh);
    asm volatile("" ::: "memory");
#pragma unroll 1
    for (int kr = 0; kr < 8; ++kr) {
        const int krow = r0 + ((kr - r0) & 7);
        const bf16_t* kbn = kbb + (size_t)((r0 + ((min(kr + 1, 7) - r0) & 7)) * 64) * NIN;
#pragma unroll
        for (int n = 0; n < 8; ++n) { const int ch = lane + 64 * n; *(LAS u32x4*)(wl + (ch >> 3) * VS + 16 * (ch & 7)) = vc[n]; }
        asm volatile("" ::: "memory");
#pragma unroll
        for (int n = 0; n < 8; ++n) vc[n] = LDV(kbn, n);
        asm volatile("" ::: "memory");
        LAS const float* brow = btab + (krow - r + 7) * 31 - 1 + c0;
        bf16x8 pf[6];
        bf16x8 dummy;
        f32x4 sA[3], sB[3]; float bA[3][4], bB[3][4];
        qk<0>(kf, qlds, brow, sA, bA);
        qk<1>(kf, qlds, brow, sB, bB);
        sm<0>(sA, bA, m0[0], mrun[0], lrun[0], o[0], pf[0], dummy);
        qk<2>(kf, qlds, brow, sA, bA);
        sm<1>(sB, bB, m0[1], mrun[1], lrun[1], o[1], pf[1], pf[2]);
        qk<3>(kf, qlds, brow, sB, bB);
        asm volatile("" ::: "memory");
#pragma unroll
        for (int kt = 0; kt < 4; ++kt)
#pragma unroll
            for (int dh = 0; dh < 2; ++dh) kf[kt][dh] = LDK(kbn, kt, dh);
        asm volatile("" ::: "memory");
        sm<2>(sA, bA, m0[2], mrun[2], lrun[2], o[2], pf[3], pf[4]);
        sm<3>(sB, bB, m0[3], mrun[3], lrun[3], o[3], dummy, pf[5]);
#pragma unroll
        for (int dt = 0; dt < 4; ++dt) {
            const bf16x8 a01 = cat8(vtr(vrd + 32 * dt), vtr(vrd + 16 * VS + 32 * dt)), a23 = cat8(vtr(vrd + 32 * VS + 32 * dt), vtr(vrd + 48 * VS + 32 * dt));
            o[0][dt] = __builtin_amdgcn_mfma_f32_16x16x32_bf16(a01, pf[0], o[0][dt], 0, 0, 0);
            o[1][dt] = __builtin_amdgcn_mfma_f32_16x16x32_bf16(a01, pf[1], o[1][dt], 0, 0, 0);
            o[1][dt] = __builtin_amdgcn_mfma_f32_16x16x32_bf16(a23, pf[2], o[1][dt], 0, 0, 0);
            o[2][dt] = __builtin_amdgcn_mfma_f32_16x16x32_bf16(a01, pf[3], o[2][dt], 0, 0, 0);
            o[2][dt] = __builtin_amdgcn_mfma_f32_16x16x32_bf16(a23, pf[4], o[2][dt], 0, 0, 0);
            o[3][dt] = __builtin_amdgcn_mfma_f32_16x16x32_bf16(a23, pf[5], o[3][dt], 0, 0, 0);
        }
    }
#pragma unroll
    for (int jq = 0; jq < 4; ++jq) {
        const float lt = xrow16_sum(lrun[jq]);
        const float inv = 1.0f / lt; float ss = 0.f;
#pragma unroll
        for (int dt = 0; dt < 4; ++dt) { o[jq][dt] *= inv; ss += (o[jq][dt][0] * o[jq][dt][0] + o[jq][dt][1] * o[jq][dt][1]) + (o[jq][dt][2] * o[jq][dt][2] + o[jq][dt][3] * o[jq][dt][3]); }
        ss = xrow16_sum(ss);
        if (g == 0) ssbuf[h * 64 + 16 * jq + i] = ss;
    }
    __syncthreads();
    bf16_t* mo = MIX + ((size_t)b * SEQ + r * 64) * DM + h * 64 + 4 * g;
#pragma unroll
    for (int jq = 0; jq < 4; ++jq) {
        float tot = 0.f;
#pragma unroll
        for (int hh = 0; hh < 8; ++hh) tot += ssbuf[hh * 64 + 16 * jq + i];
        const float rinv = __builtin_amdgcn_rsqf(tot * (1.0f / 512.0f) + EPS);
#pragma unroll
        for (int dt = 0; dt < 4; ++dt) { const f32x4 v = o[jq][dt] * rinv;
            *(unsigned long long*)(mo + (size_t)(16 * jq + i) * DM + 16 * dt) = (unsigned long long)pg8::cvt_pk_bf16(v[0], v[1]) | ((unsigned long long)pg8::cvt_pk_bf16(v[2], v[3]) << 32); }
    }
    __syncthreads();
}

#undef LDK
#undef LDV
__device__ __forceinline__ void mixer_conv(const bf16_t* Z, bf16_t* MIX, const float* convw, int b, int r) {
    int tid_l = threadIdx.x; asm volatile("" : "+v"(tid_l));
    const int tid = tid_l, lane = tid & 63, wave = tid >> 6, ch = 8 * lane;
    float w[3][8];
#pragma unroll
    for (int k = 0; k < 3; ++k) { const f32x4 a = *(const f32x4*)(convw + k * 512 + ch), c = *(const f32x4*)(convw + k * 512 + ch + 4);
#pragma unroll
        for (int e = 0; e < 4; ++e) { w[k][e] = a[e]; w[k][4 + e] = c[e]; } }
#pragma unroll 1
    for (int half = 0; half < 2; ++half) {
        const int s0 = r * 64 + wave * 8 + half * 4;
        const bf16_t* base = Z + ((size_t)b * SEQ + s0) * NIN + ch;
        const u32x4 z4 = {0u, 0u, 0u, 0u};
        u32x4 ccw[6], cuw[6], cbw[4];
#pragma unroll
        for (int j = 0; j < 6; ++j) { const int s = s0 - 1 + j; const bool in = (s >= 0) && (s < SEQ); const bf16_t* p = base + (ptrdiff_t)(j - 1) * NIN;
            ccw[j] = in ? *(const u32x4*)(p + 2048) : z4; cuw[j] = in ? *(const u32x4*)(p + 2560) : z4; }
#pragma unroll
        for (int j = 0; j < 4; ++j) cbw[j] = *(const u32x4*)(base + (size_t)j * NIN + 1536);
        float u[6][8];
#pragma unroll
        for (int j = 0; j < 6; ++j) { float c8[8], u8[8]; unpack8(ccw[j], c8); unpack8(cuw[j], u8);
#pragma unroll
            for (int e = 0; e < 8; ++e) u[j][e] = c8[e] * u8[e]; }
        float cv[4][8], ss[4];
#pragma unroll
        for (int j = 0; j < 4; ++j) { float cb[8]; unpack8(cbw[j], cb); ss[j] = 0.f;
#pragma unroll
            for (int e = 0; e < 8; ++e) { cv[j][e] = cb[e] * (w[0][e] * u[j][e] + w[1][e] * u[j + 1][e] + w[2][e] * u[j + 2][e]); ss[j] += cv[j][e] * cv[j][e]; } }
#pragma unroll
        for (int o = 1; o < 64; o <<= 1)
#pragma unroll
            for (int j = 0; j < 4; ++j) ss[j] += __shfl_xor(ss[j], o);
#pragma unroll
        for (int j = 0; j < 4; ++j) { const float rinv = __builtin_amdgcn_rsqf(ss[j] * (1.0f / 512.0f) + EPS);
            u32x4 o; o.x = pg8::cvt_pk_bf16(cv[j][0] * rinv, cv[j][1] * rinv); o.y = pg8::cvt_pk_bf16(cv[j][2] * rinv, cv[j][3] * rinv); o.z = pg8::cvt_pk_bf16(cv[j][4] * rinv, cv[j][5] * rinv); o.w = pg8::cvt_pk_bf16(cv[j][6] * rinv, cv[j][7] * rinv);
            *(u32x4*)(MIX + ((size_t)b * SEQ + s0 + j) * DM + 512 + ch) = o; }
    }
}

__device__ __forceinline__ void mixer_phase(const bf16_t* Z, bf16_t* MIX, const float* rpb, const float* convw, int u0, int u1, int ustep, LAS unsigned char* lds) {
    int tid_l = threadIdx.x; asm volatile("" : "+v"(tid_l));
    const int tid = tid_l, lane = tid & 63, h = tid >> 6;
    LAS float* btab = (LAS float*)(lds + h * WREG + BT_OFF);
    for (int e = lane; e < 15 * 31; e += 64) btab[e] = rpb[h * 15 * 31 + e] * 1.44269504088896f;
    __syncthreads();
    for (int u = u0; u < u1; u += ustep) { mixer_attn(Z, MIX, u >> 6, u & 63, lds); mixer_conv(Z, MIX, convw, u >> 6, u & 63); }
}

__device__ __forceinline__ void group_barrier(unsigned* ctr, unsigned& gen, const bool same_xcc) {
    asm volatile("s_waitcnt vmcnt(0)" ::: "memory");
    __syncthreads();
    gen += 32u;
    int tid_l = threadIdx.x; asm volatile("" : "+v"(tid_l));
    if (tid_l == 0) {
        if (!same_xcc) {
            __builtin_amdgcn_fence(__ATOMIC_RELEASE, "agent");
            asm volatile("s_waitcnt vmcnt(0)" ::: "memory"); }
        __hip_atomic_fetch_add(ctr, 1u, __ATOMIC_RELAXED, __HIP_MEMORY_SCOPE_AGENT);
        while (__hip_atomic_load(ctr, __ATOMIC_RELAXED, __HIP_MEMORY_SCOPE_AGENT) < gen) __builtin_amdgcn_s_sleep(2);
        __builtin_amdgcn_fence(__ATOMIC_ACQUIRE, "agent");
        asm volatile("s_waitcnt vmcnt(0)" ::: "memory");
    }
    __syncthreads();
}
__device__ __forceinline__ void group_arrive(unsigned* ctr, unsigned& gen, const bool same_xcc) {
    asm volatile("s_waitcnt vmcnt(0)" ::: "memory");
    __syncthreads();
    gen += 32u;
    int tid_l = threadIdx.x; asm volatile("" : "+v"(tid_l));
    if (tid_l == 0) {
        if (!same_xcc) {
            __builtin_amdgcn_fence(__ATOMIC_RELEASE, "agent");
            asm volatile("s_waitcnt vmcnt(0)" ::: "memory"); }
        __hip_atomic_fetch_add(ctr, 1u, __ATOMIC_RELAXED, __HIP_MEMORY_SCOPE_AGENT);
    }
}
__device__ __forceinline__ void group_wait(unsigned* ctr, unsigned gen) {
    int tid_l = threadIdx.x; asm volatile("" : "+v"(tid_l));
    if (tid_l == 0) {
        while (__hip_atomic_load(ctr, __ATOMIC_RELAXED, __HIP_MEMORY_SCOPE_AGENT) < gen) __builtin_amdgcn_s_sleep(2);
        __builtin_amdgcn_fence(__ATOMIC_ACQUIRE, "agent");
        asm volatile("s_waitcnt vmcnt(0)" ::: "memory");
    }
    __syncthreads();
}
__global__ void __launch_bounds__(512, 2) mega(Args A) {
    extern __shared__ __attribute__((aligned(16))) unsigned char lds_raw[];
    LAS unsigned char* lds = (LAS unsigned char*)lds_raw;
    cg::grid_group grid = cg::this_grid();
    const int G = gridDim.x, bx = blockIdx.x;
    const int vcu = (G % 8 == 0) ? (bx % 8) * (G / 8) + bx / 8 : bx;
    unsigned char* ws = A.ws;
    float* part[2] = {(float*)(ws + WS_PART0), (float*)(ws + WS_PART1)};
    bf16_t* const HB0 = (bf16_t*)(ws + WS_HB); bf16_t* const HB1 = (bf16_t*)(ws + WS_HB1);
    bf16_t* Z = (bf16_t*)(ws + WS_Z); bf16_t* ACT = Z; bf16_t* MIX = (bf16_t*)(ws + WS_MIX); bf16_t* PP = MIX;

    if (bx == 0 && threadIdx.x < 8) __hip_atomic_store((unsigned*)(ws + WS_BAR) + 64 * threadIdx.x, 0u, __ATOMIC_RELAXED, __HIP_MEMORY_SCOPE_AGENT);
    const unsigned my_xcc = (unsigned)__builtin_amdgcn_s_getreg((3 << 11) | 20) & 0xFu;
    if (threadIdx.x == 0) __hip_atomic_store((unsigned*)(ws + WS_BAR + 4096) + bx, my_xcc, __ATOMIC_RELAXED, __HIP_MEMORY_SCOPE_AGENT);
#ifndef NO_P0
    prologue(A, lds);
#endif
    grid.sync();
    bool same_xcc = false;
    if (G == 256) { const unsigned t = threadIdx.x & 31u;
        const unsigned other = __hip_atomic_load((unsigned*)(ws + WS_BAR + 4096) + (bx & 7) + 8 * t, __ATOMIC_RELAXED, __HIP_MEMORY_SCOPE_AGENT);
        same_xcc = __builtin_amdgcn_ballot_w64(other != my_xcc) == 0ull; }
    const bool grouped = (G == 256);
    unsigned* const gctr = (unsigned*)(ws + WS_BAR) + 64 * (bx & 7); unsigned ggen = 0u;
#define SEAM() do { if (grouped) group_barrier(gctr, ggen, same_xcc); else grid.sync(); } while (0)

    int np = 0;
    for (int L = 0; L < DEPTH; ++L) {
        unsigned char* wl = ws + WS_W + (size_t)L * W_LAYER;
        bf16_t* HB = (L & 1) ? HB1 : HB0; bf16_t* HBn = (L & 1) ? HB0 : HB1;
        {
            pg8::Gemm g{HB, (const bf16_t*)(wl + WO_IN), MTOK, NIN, DM, DM}; pg8::StaticOrder S; S.init(MTOK, NIN, G, bx);
            Epi<0> E{Z, NIN, part[np & 1], nullptr, nullptr, nullptr};
#ifndef NO_G1
            pg8::gemm_phase<Epi<0>, pg8::StaticOrder, true, true>(lds, g, S, E);
#endif
        }
        SEAM();
        {
            const float* rpb = A.in[I_RPB] + (size_t)L * 8 * 15 * 31; const float* cw = A.in[I_CONVW] + (size_t)L * 3 * 512;
#ifndef NO_MIX
            mixer_phase(Z, MIX, rpb, cw, grouped ? 128 * (bx & 7) + (bx >> 3) : bx, grouped ? 128 * (bx & 7) + 128 : 1024, grouped ? 32 : G, lds);
#endif
        }
        SEAM();
        {
            pg8::Gemm g{MIX, (const bf16_t*)(wl + WO_OUT), MTOK, DM, DM, DM}; pg8::StaticOrder S; S.init(MTOK, DM, G, bx);
            Epi<3> E{HB, DM, nullptr, HB, part[(np + 1) & 1], nullptr};
#ifndef NO_G2
            pg8::gemm_phase<Epi<3>, pg8::StaticOrder, true, true>(lds, g, S, E);
#endif
            ++np;
        }
        SEAM();
        {
            pg8::Gemm g{HB, (const bf16_t*)(wl + WO_GU), MTOK, NGU, DM, DM}; pg8::StaticOrder S; S.init(MTOK, NGU, G, bx);
            Epi<1> E{ACT, NIN, part[np & 1], nullptr, nullptr, nullptr};
#ifndef NO_G3
            pg8::gemm_phase<Epi<1>, pg8::StaticOrder, true, true>(lds, g, S, E);
#endif
        }
        if (grouped) group_arrive(gctr, ggen, same_xcc); else grid.sync();
        {
            pg8::Gemm g{(const bf16_t*)(ws + WS_PB) + (size_t)L * MTOK * PLE, (const bf16_t*)(wl + WO_PP), MTOK, DM, PLE, PLE}; pg8::StaticOrder S; S.init(MTOK, DM, G, bx);
            Epi<2> E{PP, DM, nullptr, nullptr, nullptr, nullptr};
#ifndef NO_G5
            pg8::gemm_phase<Epi<2>, pg8::StaticOrder, true, true>(lds, g, S, E);
#endif
        }
        if (grouped) group_wait(gctr, ggen);
        {
            pg8::Gemm g{ACT, (const bf16_t*)(wl + WO_DOWN), MTOK, DM, DFF, NIN}; pg8::StaticOrder S; S.init(MTOK, DM, G, bx);
            Epi<3> E{HB, DM, nullptr, HB, part[(np + 1) & 1], nullptr};
#ifndef NO_G4
            pg8::gemm_phase<Epi<3>, pg8::StaticOrder, true, true>(lds, g, S, E);
#endif
            ++np;
        }
        SEAM();
        {
            pg8::Gemm g{HB, (const bf16_t*)(wl + WO_PG), MTOK, DM, DM, DM}; pg8::StaticOrder S; S.init(MTOK, DM, G, bx);
            Epi<4> E{HBn, DM, part[np & 1], HB, part[(np + 1) & 1], PP};
#ifndef NO_G6
            pg8::gemm_phase<Epi<4>, pg8::StaticOrder, true, true>(lds, g, S, E);
#endif
            ++np;
        }
        SEAM();
    }
    if (!grouped) grid.sync();
    {
        static_assert(DEPTH % 2 == 0, "the final residual stream must end in the d_ws copy");
        int tid_l = threadIdx.x; asm volatile("" : "+v"(tid_l));
        const int lane = tid_l & 63, wave = tid_l >> 6; const float* gf = A.in[I_GFINAL]; const float* pr = part[np & 1];
        f32x4 gv[4];
#pragma unroll
        for (int j = 0; j < 4; ++j) gv[j] = *((const f32x4*)gf + lane + 64 * j);
        const int m0 = grouped ? 8192 * (bx & 7) + (bx >> 3) * 8 + wave : bx * 8 + wave, m1 = grouped ? 8192 * (bx & 7) + 8192 : MTOK, ms = grouped ? 256 : G * 8;
        for (int m = m0; m < m1; m += 4 * ms) {
            float rinv[4]; unsigned long long w[4][4];
#pragma unroll
            for (int q = 0; q < 4; ++q) { const int mq = (m + q * ms < m1) ? m + q * ms : m; rinv[q] = row_rinv(pr, mq);
                const unsigned long long* hr = (const unsigned long long*)(HB0 + (size_t)mq * DM) + lane;
#pragma unroll
                for (int j = 0; j < 4; ++j) w[q][j] = hr[64 * j]; }
#pragma unroll
            for (int q = 0; q < 4; ++q) if (m + q * ms < m1) { f32x4* orow = (f32x4*)(A.out + (size_t)(m + q * ms) * DM) + lane;
#pragma unroll
                for (int j = 0; j < 4; ++j) { const unsigned lo = (unsigned)w[q][j], hi = (unsigned)(w[q][j] >> 32);
                    const f32x4 v = {bf_lo(lo), bf_hi(lo), bf_lo(hi), bf_hi(hi)}; orow[64 * j] = v * rinv[q] * gv[j]; } }
        }
    }
}

extern "C" void kernel_launch(void* const* d_in, const int* in_sizes, int n_in, void* d_out, int out_size, void* d_ws, size_t ws_size, hipStream_t stream) {
    static int grid = 0;
    if (grid == 0) {
        if (n_in != 17 || out_size != MTOK * DM || ws_size < WS_END) { fprintf(stderr, "kernel_launch: unexpected shapes (n_in %d out %d ws %zu)\n", n_in, out_size, ws_size); grid = -1; return; }
        int dev = 0, cus = 0, per_cu = 0;
        hipGetDevice(&dev); hipDeviceGetAttribute(&cus, hipDeviceAttributeMultiprocessorCount, dev);
        hipFuncSetAttribute((const void*)mega, hipFuncAttributeMaxDynamicSharedMemorySize, LDS_BYTES);
        hipOccupancyMaxActiveBlocksPerMultiprocessor(&per_cu, (const void*)mega, 512, LDS_BYTES);
        if (per_cu < 1) { fprintf(stderr, "kernel_launch: occupancy query says %d blocks per CU\n", per_cu); per_cu = 1; }
        (void)hipGetLastError();
        grid = cus * per_cu;
    }
    if (grid < 0) return;
    Args a{};
    for (int i = 0; i < 17; ++i) a.in[i] = (const float*)d_in[i];
    a.out = (float*)d_out; a.ws = (unsigned char*)d_ws;
    void* args[] = {&a};
    hipError_t e = hipLaunchCooperativeKernel((const void*)mega, dim3(grid), dim3(512), args, LDS_BYTES, stream);
    if (e != hipSuccess) fprintf(stderr, "cooperative launch failed: %s (grid %d)\n", hipGetErrorString(e), grid);
}
```

```cpp
#include <hip/hip_runtime.h>
#include <hip/hip_cooperative_groups.h>
#include <cstdio>
#include <cstdint>
namespace cg = cooperative_groups;

namespace pg8 {
#define PG8_LAS __attribute__((address_space(3)))
typedef unsigned short bf16_t;
typedef short bf16x8 __attribute__((ext_vector_type(8)));
typedef float f32x4 __attribute__((ext_vector_type(4)));
typedef unsigned u32x4 __attribute__((ext_vector_type(4)));
constexpr int BM = 256, BK = 64, HALF = 128, HTB = HALF * BK * 2  , STAGE_BYTES = 8 * HTB, NXCD = 8, WGM = 8;

__host__ __device__ __forceinline__ int lds_byte(int r, int c) { const int st = (r >> 4) * 2 + (c >> 5), rr = r & 15, cc = c & 31, ob = rr * 64 + cc * 2; return st * 1024 + (ob ^ (((ob >> 9) & 1) << 5)); }
__host__ __device__ __forceinline__ void stage_rc(int b, int& R, int& C) { const int st = b / 1024, sb = b % 1024, swz = sb ^ (((sb >> 9) & 1) << 5); R = (st >> 1) * 16 + swz / 64; C = (st & 1) * 32 + (swz % 64) / 2; }
__host__ __device__ __forceinline__ int perm32(int rho) { const int n = rho >> 4, i = rho & 15; return 8 * (i >> 2) + 4 * n + (i & 3); }

struct Unit { int pm, pn; };
struct Gemm { const bf16_t* A; const bf16_t* Bt; int M, N, K, lda; };

struct StaticOrder {
    int nM, nN, nwg, G, c;
    __host__ __device__ void init(int M, int N, int G_, int c_) { nM = M / BM; nN = N / BM; nwg = nM * nN; G = G_; c = c_; }
    __host__ __device__ bool next(int i, Unit& u) const {
        const long L = (long)i * G + c; if (L >= nwg) return false;
        int wgid = (int)L; { const int q = nwg / NXCD, r = nwg % NXCD, xcd = wgid % NXCD, off = wgid / NXCD; wgid = (xcd < r ? xcd * (q + 1) : r * (q + 1) + (xcd - r) * q) + off; }
        const int nig = WGM * nN, gid = wgid / nig, fm = gid * WGM, gsz = (nM - fm) < WGM ? (nM - fm) : WGM;
        u.pm = fm + ((wgid % nig) % gsz); u.pn = (wgid % nig) / gsz; return true;
    }
    __device__ __forceinline__ void a_ready(const Unit&) const {}
    __device__ __forceinline__ void done(const Unit&) const {}
};
__device__ __forceinline__ unsigned cvt_pk_bf16(float lo, float hi) { unsigned r; asm volatile("v_cvt_pk_bf16_f32 %0, %1, %2" : "=v"(r) : "v"(lo), "v"(hi)); return r; }
template <class Epi, class Sched, bool ALIGN_EPI = false, bool SP2 = false>
__device__ __forceinline__ void gemm_phase(PG8_LAS unsigned char* lds, const Gemm g, const Sched& S, const Epi& E) {
    int tid_l = threadIdx.x; asm volatile("" : "+v"(tid_l));
    const int tid = tid_l, wid = __builtin_amdgcn_readfirstlane(tid >> 6), lane = tid & 63, wr = wid >> 2, wc = wid & 3, fr = lane & 15, fq = lane >> 4;
    int K_l = g.K; asm volatile("" : "+s"(K_l));
    const int K = K_l, nt = K / BK;
    int lda_l = g.lda; asm volatile("" : "+s"(lda_l)); const int lda = lda_l;
    unsigned voffA[2], voffB[2];
#pragma unroll
    for (int i = 0; i < 2; ++i) { int R, C; stage_rc(tid * 16 + i * 8192, R, C); const int Rb = Epi::PERM ? ((R & ~31) + perm32(R & 31)) : R;
        voffA[i] = (unsigned)(R * lda + C) * 2u; voffB[i] = (unsigned)(Rb * K + C) * 2u; }
    const size_t kstep = (size_t)(BK * 2);
    const size_t hstepA = (size_t)HALF * lda * 2, tstepA = 2 * hstepA;
    const size_t hstep = (size_t)HALF * K * 2;
    const size_t tstep = 2 * hstep;
    const unsigned ldsw = (unsigned)wid * 1024u;
    const int aoff = lds_byte(wr * 64 + fr, fq * 8), boff = lds_byte(wc * 32 + fr, fq * 8);
#define PG8_SA(b, h) (((b) * 2 + (h)) * HTB)
#define PG8_SB(b, h) ((4 + (b) * 2 + (h)) * HTB)
#define PG8_STAGE(bufoff, gbase, voff) do { _Pragma("unroll") for (int _i = 0; _i < 2; ++_i) \
        __builtin_amdgcn_global_load_lds((const unsigned*)((const char*)(gbase) + (voff)[_i]), (PG8_LAS unsigned*)(lds + (bufoff) + ldsw + _i * 8192), 16, 0, 0); } while (0)
#define PG8_LDA(dst, b, h) do { _Pragma("unroll") for (int m = 0; m < 4; ++m) _Pragma("unroll") for (int k = 0; k < 2; ++k) dst[m][k] = *(const PG8_LAS bf16x8*)(lds + PG8_SA(b, h) + aoff + m * 2048 + k * 1024); } while (0)
#define PG8_LDB(dst, b, h) do { _Pragma("unroll") for (int n = 0; n < 2; ++n) _Pragma("unroll") for (int k = 0; k < 2; ++k) dst[n][k] = *(const PG8_LAS bf16x8*)(lds + PG8_SB(b, h) + boff + n * 2048 + k * 1024); } while (0)
#define PG8_MMA(ai, bj, At, Bt) do { __builtin_amdgcn_s_setprio(1); _Pragma("unroll") for (int m = 0; m < 4; ++m) _Pragma("unroll") for (int n = 0; n < 2; ++n) _Pragma("unroll") for (int k = 0; k < 2; ++k) \
        acc[ai][bj][m][n] = __builtin_amdgcn_mfma_f32_16x16x32_bf16(Bt[n][k], At[m][k], acc[ai][bj][m][n], 0, 0, 0); __builtin_amdgcn_s_setprio(0); } while (0)
#define PG8_WAIT_V(n) asm volatile("s_waitcnt vmcnt(" #n ")" ::: "memory")
#define PG8_WAIT_SEL(d, w4, w8) do { if constexpr (Epi::SPLIT) { if (d) { if constexpr (Epi::NSH == 4) PG8_WAIT_V(w4); else PG8_WAIT_V(w8); } else PG8_WAIT_V(8); } else PG8_WAIT_V(8); } while (0)
#define PG8_WAIT_L(n) asm volatile("s_waitcnt lgkmcnt(" #n ")" ::: "memory")
#define PG8_BAR __builtin_amdgcn_s_barrier()
#define PG8_SCHED __builtin_amdgcn_sched_barrier(0)
    Unit cur, nxt, prev; int ui = 0; prev.pm = 0; prev.pn = 0;
    PG8_LAS float* const rv1 = (PG8_LAS float*)(lds + STAGE_BYTES) + tid * 4;
    if (!S.next(0, cur)) return;
    f32x4 acc[2][2][4][2];
#pragma unroll
    for (int a = 0; a < 2; ++a)
#pragma unroll
        for (int b = 0; b < 2; ++b)
#pragma unroll
            for (int m = 0; m < 4; ++m)
#pragma unroll
                for (int n = 0; n < 2; ++n) acc[a][b][m][n] = (f32x4){0.f, 0.f, 0.f, 0.f};
    bf16x8 At[4][2], B0[2][2], B1[2][2];
    const char* cA = (const char*)g.A + (size_t)cur.pm * tstepA; const char* cB = (const char*)g.Bt + (size_t)cur.pn * tstep;
    S.a_ready(cur);
    if constexpr (SP2) {
        PG8_STAGE(PG8_SB(0, 0), cB, voffB); PG8_STAGE(PG8_SB(0, 1), cB + hstep, voffB); PG8_STAGE(PG8_SA(0, 0), cA, voffA); PG8_STAGE(PG8_SA(0, 1), cA + hstepA, voffA);
        if (wr == 1) PG8_BAR;
        PG8_WAIT_V(2); PG8_BAR;
        PG8_STAGE(PG8_SB(1, 0), cB + kstep, voffB); PG8_STAGE(PG8_SA(1, 0), cA + kstep, voffA); PG8_STAGE(PG8_SB(1, 1), cB + hstep + kstep, voffB);
        PG8_WAIT_V(6); PG8_BAR;
    } else {
        PG8_STAGE(PG8_SB(0, 0), cB, voffB); PG8_STAGE(PG8_SA(0, 0), cA, voffA); PG8_STAGE(PG8_SB(0, 1), cB + hstep, voffB); PG8_STAGE(PG8_SA(0, 1), cA + hstepA, voffA);
        if (wr == 1) PG8_BAR;
        PG8_WAIT_V(4); PG8_BAR;
        PG8_STAGE(PG8_SB(1, 0), cB + kstep, voffB); PG8_STAGE(PG8_SA(1, 0), cA + kstep, voffA); PG8_STAGE(PG8_SB(1, 1), cB + hstep + kstep, voffB);
        PG8_WAIT_V(6); PG8_BAR;
    }
    for (;;) {
        const bool has_next = S.next(ui + 1, nxt);
        const char* nA = has_next ? (const char*)g.A + (size_t)nxt.pm * tstepA : cA; const char* nB = has_next ? (const char*)g.Bt + (size_t)nxt.pn * tstep : cB;
        for (int t = 0; t < nt; t += 2) {
            const bool last = (t == nt - 2);
            if constexpr (Epi::RVLDS) { if (last) {
                const char* pg = (const char*)E.part_in + (size_t)cur.pm * 16384 + (size_t)tid * 16;
                __builtin_amdgcn_global_load_lds((const unsigned*)pg, (PG8_LAS unsigned*)(lds + STAGE_BYTES + ldsw), 16, 0, 0);
                __builtin_amdgcn_global_load_lds((const unsigned*)(pg + 8192), (PG8_LAS unsigned*)(lds + STAGE_BYTES + 8192 + ldsw), 16, 0, 0); } }
            const bool plast = Epi::RVLDS && last;
            const bool defer = Epi::SPLIT && (t == 0) && (ui > 0);
            const char* a1 = cA + (size_t)(t + 1) * kstep;
            const char* a2 = last ? nA : cA + (size_t)(t + 2) * kstep; const char* b2 = last ? nB : cB + (size_t)(t + 2) * kstep;
            const char* a3 = a2 + kstep; const char* b3 = b2 + kstep;
            if (last && has_next) S.a_ready(nxt);
            if constexpr (SP2) {
            PG8_LDB(B0, 0, 0); PG8_LDB(B1, 0, 1); PG8_SCHED; PG8_LDA(At, 0, 0); PG8_STAGE(PG8_SA(1, 1), a1 + hstepA, voffA);
            if (plast) PG8_WAIT_V(10); else PG8_WAIT_SEL(defer, 12, 16);
            PG8_WAIT_L(0); PG8_BAR; PG8_MMA(0, 0, At, B0); PG8_MMA(0, 1, At, B1);
            if constexpr (Epi::SPLIT) { if (defer) {
                E.second(acc, prev, rv1, wr, wc, fr, fq);
                _Pragma("unroll") for (int b = 0; b < 2; ++b) _Pragma("unroll") for (int m = 0; m < 4; ++m) _Pragma("unroll") for (int n = 0; n < 2; ++n) acc[1][b][m][n] = (f32x4){0.f, 0.f, 0.f, 0.f}; } }
            PG8_BAR; PG8_SCHED;
            PG8_LDA(At, 0, 1); PG8_STAGE(PG8_SB(0, 0), b2, voffB); PG8_STAGE(PG8_SB(0, 1), b2 + hstep, voffB); PG8_STAGE(PG8_SA(0, 0), a2, voffA);
            if (plast) PG8_WAIT_V(10); else PG8_WAIT_SEL(defer, 16, 24);
            PG8_WAIT_L(0); PG8_BAR; PG8_MMA(1, 0, At, B0); PG8_MMA(1, 1, At, B1); PG8_BAR; PG8_SCHED;
            PG8_LDB(B0, 1, 0); PG8_LDB(B1, 1, 1); PG8_SCHED; PG8_LDA(At, 1, 0); PG8_STAGE(PG8_SA(0, 1), a2 + hstepA, voffA);
            PG8_WAIT_SEL(defer, 12, 16); PG8_WAIT_L(0); PG8_BAR; PG8_MMA(0, 0, At, B0); PG8_MMA(0, 1, At, B1); PG8_BAR; PG8_SCHED;
            PG8_LDA(At, 1, 1); PG8_STAGE(PG8_SB(1, 0), b3, voffB); PG8_STAGE(PG8_SB(1, 1), b3 + hstep, voffB); PG8_STAGE(PG8_SA(1, 0), a3, voffA);
            PG8_WAIT_V(8); PG8_WAIT_L(0); PG8_BAR; PG8_MMA(1, 0, At, B0); PG8_MMA(1, 1, At, B1); PG8_BAR; PG8_SCHED;
            } else {
            PG8_LDB(B0, 0, 0); PG8_SCHED; PG8_LDA(At, 0, 0); PG8_STAGE(PG8_SA(1, 1), a1 + hstepA, voffA);
            PG8_WAIT_L(8); PG8_BAR; PG8_WAIT_L(0); PG8_MMA(0, 0, At, B0); PG8_BAR; PG8_SCHED;
            PG8_LDB(B1, 0, 1); PG8_STAGE(PG8_SB(0, 0), b2, voffB);
            PG8_BAR; PG8_WAIT_L(0); PG8_MMA(0, 1, At, B1); PG8_BAR;
            PG8_LDA(At, 0, 1); PG8_STAGE(PG8_SA(0, 0), a2, voffA);
            PG8_BAR; PG8_WAIT_L(0); PG8_MMA(1, 0, At, B0); PG8_BAR; PG8_SCHED;
            PG8_STAGE(PG8_SB(0, 1), b2 + hstep, voffB);
            PG8_WAIT_V(6); PG8_BAR; PG8_MMA(1, 1, At, B1); PG8_BAR;
            PG8_LDB(B0, 1, 0); PG8_SCHED; PG8_LDA(At, 1, 0); PG8_STAGE(PG8_SA(0, 1), a2 + hstepA, voffA);
            PG8_WAIT_L(8); PG8_BAR; PG8_WAIT_L(0); PG8_MMA(0, 0, At, B0); PG8_BAR; PG8_SCHED;
            PG8_LDB(B1, 1, 1); PG8_STAGE(PG8_SB(1, 0), b3, voffB);
            PG8_BAR; PG8_WAIT_L(0); PG8_MMA(0, 1, At, B1); PG8_BAR;
            PG8_LDA(At, 1, 1); PG8_STAGE(PG8_SA(1, 0), a3, voffA);
            PG8_BAR; PG8_WAIT_L(0); PG8_MMA(1, 0, At, B0); PG8_BAR; PG8_SCHED;
            PG8_STAGE(PG8_SB(1, 1), b3 + hstep, voffB);
            PG8_WAIT_V(6); PG8_BAR; PG8_MMA(1, 1, At, B1); PG8_BAR;
            }
        }
        if constexpr (ALIGN_EPI) { if (wr == 0) PG8_BAR; }
        if constexpr (Epi::SPLIT) {
            if (has_next) { E.first(acc, cur, rv1, wr, wc, fr, fq); prev = cur; }
            else E(acc, cur, wr, wc, fr, fq, lds + STAGE_BYTES);
        } else if constexpr (!Epi::AFTER_DRAIN) { E(acc, cur, wr, wc, fr, fq, lds + STAGE_BYTES); S.done(cur); }
        if (!has_next) break;
#pragma unroll
        for (int a = 0; a < (Epi::SPLIT ? 1 : 2); ++a)
#pragma unroll
            for (int b = 0; b < 2; ++b)
#pragma unroll
                for (int m = 0; m < 4; ++m)
#pragma unroll
                    for (int n = 0; n < 2; ++n) acc[a][b][m][n] = (f32x4){0.f, 0.f, 0.f, 0.f};
        cur = nxt; cA = nA; cB = nB; ++ui;
        if constexpr (ALIGN_EPI) { if (wr == 1) PG8_BAR; }
    }
    PG8_WAIT_V(0);
    if constexpr (!ALIGN_EPI) { if (wr == 0) PG8_BAR; }
    PG8_BAR;
    if constexpr (Epi::AFTER_DRAIN) { E.fused(acc, cur, wr, wc, fr, fq, lds, wid, lane); S.done(cur); }
#undef PG8_SA
#undef PG8_SB
#undef PG8_STAGE
#undef PG8_LDA
#undef PG8_LDB
#undef PG8_MMA
#undef PG8_WAIT_V
#undef PG8_WAIT_SEL
#undef PG8_WAIT_L
#undef PG8_BAR
#undef PG8_SCHED
}
}

using pg8::bf16_t; using pg8::f32x4; using pg8::u32x4; using pg8::bf16x8;
#define LAS __attribute__((address_space(3)))
constexpr int DM = 1024, MTOK = 65536, SEQ = 4096, NIN = 3072, DFF = 2816, NGU = 2 * DFF, PLE = 256, DEPTH = 4;
constexpr float EPS = 1e-6f;
constexpr size_t MiB = 1u << 20;
constexpr size_t WS_PART0 = 0, WS_PART1 = 4 * MiB;
constexpr size_t WS_W = 8 * MiB, W_LAYER = 27 * MiB;
constexpr size_t WO_IN = 0, WO_OUT = 6 * MiB, WO_GU = 8 * MiB, WO_DOWN = 19 * MiB, WO_PG = 24 * MiB + MiB / 2, WO_PP = 26 * MiB + MiB / 2;
constexpr size_t WS_HB = 128 * MiB;
constexpr size_t WS_Z = 256 * MiB;
constexpr size_t WS_MIX = 640 * MiB;
constexpr size_t WS_PB = 768 * MiB;
constexpr size_t WS_BAR = 120 * MiB;
constexpr size_t WS_HB1 = 896 * MiB;
constexpr size_t WS_END = 1024 * MiB;
constexpr int LDS_BYTES = 163840;

__device__ __forceinline__ float bf_lo(unsigned w) { return __uint_as_float(w << 16); }
__device__ __forceinline__ float bf_hi(unsigned w) { return __uint_as_float(w & 0xffff0000u); }
__device__ __forceinline__ float fast_sigmoid(float x) { return __builtin_amdgcn_rcpf(1.0f + __expf(-x)); }

__device__ __forceinline__ float xrow16_max(float x) {
    auto s = __builtin_amdgcn_permlane16_swap(__float_as_uint(x), __float_as_uint(x), false, false);
    x = fmaxf(__uint_as_float(s[0]), __uint_as_float(s[1]));
    auto t = __builtin_amdgcn_permlane32_swap(__float_as_uint(x), __float_as_uint(x), false, false);
    return fmaxf(__uint_as_float(t[0]), __uint_as_float(t[1]));
}
__device__ __forceinline__ float xrow16_sum(float x) {
    auto s = __builtin_amdgcn_permlane16_swap(__float_as_uint(x), __float_as_uint(x), false, false);
    x = __uint_as_float(s[0]) + __uint_as_float(s[1]);
    auto t = __builtin_amdgcn_permlane32_swap(__float_as_uint(x), __float_as_uint(x), false, false);
    return __uint_as_float(t[0]) + __uint_as_float(t[1]);
}
__device__ __forceinline__ float row_rinv(const float* part, int row) {
    const f32x4* p = (const f32x4*)(part + (size_t)row * 16);
    const f32x4 s = (p[0] + p[1]) + (p[2] + p[3]);
    return __builtin_amdgcn_rsqf(((s[0] + s[1]) + (s[2] + s[3])) * (1.0f / 1024.0f) + EPS);
}

template <int MODE> struct Epi {
    static constexpr bool PERM = true, AFTER_DRAIN = false;
    static constexpr bool SPLIT = false;
    static constexpr bool RVLDS = (MODE == 0 || MODE == 1 || MODE == 4);
    static constexpr int NSH = (MODE == 1) ? 4 : 8;
    bf16_t* O; int ldc; const float* part_in; const bf16_t* h_old; float* part_out; const bf16_t* pp;
    template <int AI> __device__ __forceinline__ void store_half(const f32x4 (&acc)[2][2][4][2], const pg8::Unit& u, const float (&rvh)[4], int wr, int wc, int fr, int fq) const {
        const int row0 = u.pm * 256 + wr * 64 + fr;
#pragma unroll
        for (int m = 0; m < 4; ++m) {
            const int row = row0 + AI * 128 + m * 16;
            const float rinv = (MODE == 2) ? 1.f : rvh[m];
            if (MODE == 0 || MODE == 2) {
                bf16_t* rowp = O + (size_t)row * ldc + u.pn * 256 + wc * 32 + 8 * fq;
#pragma unroll
                for (int bj = 0; bj < 2; ++bj) { const f32x4 v0 = acc[AI][bj][m][0] * rinv, v1 = acc[AI][bj][m][1] * rinv;
                    u32x4 w; w.x = pg8::cvt_pk_bf16(v0[0], v0[1]); w.y = pg8::cvt_pk_bf16(v0[2], v0[3]); w.z = pg8::cvt_pk_bf16(v1[0], v1[1]); w.w = pg8::cvt_pk_bf16(v1[2], v1[3]);
                    *(u32x4*)(rowp + bj * 128) = w; }
            } else {
                bf16_t* rowp = O + (size_t)row * ldc + u.pn * 128 + wc * 32 + 8 * fq;
                float a[8];
#pragma unroll
                for (int n = 0; n < 2; ++n)
#pragma unroll
                    for (int j = 0; j < 4; ++j) { const float g = acc[AI][0][m][n][j] * rinv, up = acc[AI][1][m][n][j] * rinv; a[4 * n + j] = g * fast_sigmoid(g) * up; }
                u32x4 w; w.x = pg8::cvt_pk_bf16(a[0], a[1]); w.y = pg8::cvt_pk_bf16(a[2], a[3]); w.z = pg8::cvt_pk_bf16(a[4], a[5]); w.w = pg8::cvt_pk_bf16(a[6], a[7]);
                *(u32x4*)rowp = w;
            }
            asm volatile("" ::: "memory");
        }
    }
    __device__ __forceinline__ void first(const f32x4 (&acc)[2][2][4][2], const pg8::Unit& u, LAS float* rv1p, int wr, int wc, int fr_, int fq_) const {
        int fr = fr_, fq = fq_; asm volatile("" : "+v"(fr), "+v"(fq));
        const int row0 = u.pm * 256 + wr * 64 + fr;
        float rv0[4] = {1.f, 1.f, 1.f, 1.f}, rv1[4] = {1.f, 1.f, 1.f, 1.f};
        if (MODE != 2) {
            float t[2][4];
#pragma unroll
            for (int ai = 0; ai < 2; ++ai)
#pragma unroll
                for (int m = 0; m < 4; ++m) { const f32x4 pv = *((const f32x4*)(part_in + (size_t)(row0 + ai * 128 + m * 16) * 16) + fq); t[ai][m] = (pv[0] + pv[1]) + (pv[2] + pv[3]); }
#pragma unroll
            for (int m = 0; m < 4; ++m) { rv0[m] = __builtin_amdgcn_rsqf(xrow16_sum(t[0][m]) * (1.0f / 1024.0f) + EPS); rv1[m] = __builtin_amdgcn_rsqf(xrow16_sum(t[1][m]) * (1.0f / 1024.0f) + EPS); }
        }
        if (MODE != 2) *(LAS f32x4*)rv1p = (f32x4){rv1[0], rv1[1], rv1[2], rv1[3]};
        store_half<0>(acc, u, rv0, wr, wc, fr, fq);
    }
    __device__ __forceinline__ void second(const f32x4 (&acc)[2][2][4][2], const pg8::Unit& u, LAS const float* rv1p, int wr, int wc, int fr_, int fq_) const {
        int fr = fr_, fq = fq_; asm volatile("" : "+v"(fr), "+v"(fq));
        float rv1[4] = {1.f, 1.f, 1.f, 1.f};
        if (MODE != 2) { const f32x4 t = *(LAS const f32x4*)rv1p; rv1[0] = t[0]; rv1[1] = t[1]; rv1[2] = t[2]; rv1[3] = t[3]; }
        store_half<1>(acc, u, rv1, wr, wc, fr, fq);
    }
    __device__ __forceinline__ void operator()(const f32x4 (&acc)[2][2][4][2], const pg8::Unit& u, int wr, int wc, int fr_, int fq_, LAS const unsigned char* xl) const {
        int fr = fr_, fq = fq_; asm volatile("" : "+v"(fr), "+v"(fq));
        const int row0 = u.pm * 256 + wr * 64 + fr;
        float rv[2][4];
        if (MODE == 0 || MODE == 1 || MODE == 4) {
#pragma unroll
            for (int ai = 0; ai < 2; ++ai)
#pragma unroll
                for (int m = 0; m < 4; ++m) { const f32x4 pv = *(LAS const f32x4*)(xl + (ai * 128 + wr * 64 + m * 16 + fr) * 64 + fq * 16); rv[ai][m] = (pv[0] + pv[1]) + (pv[2] + pv[3]); }
#pragma unroll
            for (int ai = 0; ai < 2; ++ai)
#pragma unroll
                for (int m = 0; m < 4; ++m) rv[ai][m] = __builtin_amdgcn_rsqf(xrow16_sum(rv[ai][m]) * (1.0f / 1024.0f) + EPS);
        }
        if (MODE == 0 || MODE == 1 || MODE == 2) {
#pragma unroll
            for (int ai = 0; ai < 2; ++ai)
#pragma unroll
                for (int m = 0; m < 4; ++m) {
                    const int row = row0 + ai * 128 + m * 16;
                    const float rinv = (MODE == 2) ? 1.f : rv[ai][m];
                    if (MODE == 0 || MODE == 2) {
                        bf16_t* rowp = O + (size_t)row * ldc + u.pn * 256 + wc * 32 + 8 * fq;
#pragma unroll
                        for (int bj = 0; bj < 2; ++bj) { const f32x4 v0 = acc[ai][bj][m][0] * rinv, v1 = acc[ai][bj][m][1] * rinv;
                            u32x4 w; w.x = pg8::cvt_pk_bf16(v0[0], v0[1]); w.y = pg8::cvt_pk_bf16(v0[2], v0[3]); w.z = pg8::cvt_pk_bf16(v1[0], v1[1]); w.w = pg8::cvt_pk_bf16(v1[2], v1[3]);
                            *(u32x4*)(rowp + bj * 128) = w; }
                    } else {
                        bf16_t* rowp = O + (size_t)row * ldc + u.pn * 128 + wc * 32 + 8 * fq;
                        float a[8];
#pragma unroll
                        for (int n = 0; n < 2; ++n)
#pragma unroll
                            for (int j = 0; j < 4; ++j) { const float g = acc[ai][0][m][n][j] * rinv, up = acc[ai][1][m][n][j] * rinv; a[4 * n + j] = g * fast_sigmoid(g) * up; }
                        u32x4 w; w.x = pg8::cvt_pk_bf16(a[0], a[1]); w.y = pg8::cvt_pk_bf16(a[2], a[3]); w.z = pg8::cvt_pk_bf16(a[4], a[5]); w.w = pg8::cvt_pk_bf16(a[6], a[7]);
                        *(u32x4*)rowp = w;
                    }
                }
        } else {
            const int col = u.pn * 256 + wc * 32 + 8 * fq;
            constexpr int MB = (MODE == 4) ? 2 : 4;
#pragma unroll
            for (int ai = 0; ai < 2; ++ai)
#pragma unroll
            for (int mb = 0; mb < 4; mb += MB) {
                u32x4 hw[MB][2], pw[MB][2];
#pragma unroll
                for (int m = 0; m < MB; ++m)
#pragma unroll
                    for (int bj = 0; bj < 2; ++bj) { const size_t off = (size_t)(row0 + ai * 128 + (mb + m) * 16) * DM + col + bj * 128;
                        hw[m][bj] = *(const u32x4*)(h_old + off); if (MODE == 4) pw[m][bj] = *(const u32x4*)(pp + off); }
#pragma unroll
                for (int mm = 0; mm < MB; ++mm) {
                    const int m = mb + mm;
                    const int row = row0 + ai * 128 + m * 16; const float rinv = rv[ai][m];
                    float ss = 0.f;
#pragma unroll
                    for (int bj = 0; bj < 2; ++bj) { const size_t off = (size_t)row * DM + col + bj * 128;
                        const u32x4 h4 = hw[mm][bj];
                        f32x4 a = {bf_lo(h4.x), bf_hi(h4.x), bf_lo(h4.y), bf_hi(h4.y)}, b = {bf_lo(h4.z), bf_hi(h4.z), bf_lo(h4.w), bf_hi(h4.w)};
                        f32x4 d0 = acc[ai][bj][m][0], d1 = acc[ai][bj][m][1];
                        if (MODE == 4) { const u32x4 p4 = pw[mm][bj];
                            d0[0] = fast_sigmoid(d0[0] * rinv) * bf_lo(p4.x); d0[1] = fast_sigmoid(d0[1] * rinv) * bf_hi(p4.x);
                            d0[2] = fast_sigmoid(d0[2] * rinv) * bf_lo(p4.y); d0[3] = fast_sigmoid(d0[3] * rinv) * bf_hi(p4.y);
                            d1[0] = fast_sigmoid(d1[0] * rinv) * bf_lo(p4.z); d1[1] = fast_sigmoid(d1[1] * rinv) * bf_hi(p4.z);
                            d1[2] = fast_sigmoid(d1[2] * rinv) * bf_lo(p4.w); d1[3] = fast_sigmoid(d1[3] * rinv) * bf_hi(p4.w); }
                        a += d0; b += d1;
                        u32x4 w; w.x = pg8::cvt_pk_bf16(a[0], a[1]); w.y = pg8::cvt_pk_bf16(a[2], a[3]); w.z = pg8::cvt_pk_bf16(b[0], b[1]); w.w = pg8::cvt_pk_bf16(b[2], b[3]);
                        *(u32x4*)(O + off) = w;
                        ss += (a[0] * a[0] + a[1] * a[1]) + (a[2] * a[2] + a[3] * a[3]) + (b[0] * b[0] + b[1] * b[1]) + (b[2] * b[2] + b[3] * b[3]); }
                    ss = xrow16_sum(ss);
                    if (fq == 0) part_out[(size_t)row * 16 + u.pn * 4 + wc] = ss;
                }
            }
        }
    }
};

struct Args { const float* in[17]; float* out; unsigned char* ws; };
enum { I_X = 0, I_P, I_GMIX, I_WIN, I_RPB, I_CONVW, I_GATT, I_GCONV, I_WOUT, I_GFFN, I_WGATE, I_WUP, I_WDOWN, I_GPLE, I_WPG, I_WPP, I_GFINAL };

__device__ __forceinline__ float wave_sum(float v) {
#pragma unroll
    for (int o = 1; o < 64; o <<= 1) v += __shfl_xor(v, o);
    return v;
}
__device__ __forceinline__ void transpose_item(const float* W, int K, int N, bf16_t* WT, int mapmode, const float* ga, const float* gb, int ksplit, int qcols, LAS float* scr, int item, int lane) {
    const int nblk = N / 64, kb = item / nblk, nb = item % nblk, k0 = 64 * kb, n0 = 64 * nb;
    const float cs = (n0 < qcols) ? 0.125f * 1.44269504088896f : 1.0f;
    const int kl = lane >> 4, n4 = (lane & 15) * 4;
    f32x4 v[16];
#pragma unroll
    for (int i = 0; i < 16; ++i) v[i] = *(const f32x4*)(W + (size_t)(k0 + 4 * i + kl) * N + n0 + n4);
#pragma unroll
    for (int i = 0; i < 16; ++i) { const int kk = 4 * i + kl, k = k0 + kk;
        float g = cs; if (ga) g *= (k < ksplit) ? ga[k] : gb[k - ksplit];
        LAS float* d = scr + kk * 65 + n4; d[0] = v[i][0] * g; d[1] = v[i][1] * g; d[2] = v[i][2] * g; d[3] = v[i][3] * g; }
    asm volatile("s_waitcnt lgkmcnt(0)" ::: "memory");
    const int c = lane & 7;
    const int rbase = (mapmode == 0) ? n0 : (256 * (n0 >> 7) + (n0 & 127) + (mapmode == 2 ? 128 : 0));
#pragma unroll
    for (int j = 0; j < 8; ++j) { const int n = (lane >> 3) + 8 * j; const LAS float* sp = scr + (8 * c) * 65 + n;
        u32x4 o; o.x = pg8::cvt_pk_bf16(sp[0 * 65], sp[1 * 65]); o.y = pg8::cvt_pk_bf16(sp[2 * 65], sp[3 * 65]); o.z = pg8::cvt_pk_bf16(sp[4 * 65], sp[5 * 65]); o.w = pg8::cvt_pk_bf16(sp[6 * 65], sp[7 * 65]);
        *(u32x4*)(WT + (size_t)(rbase + n) * K + k0 + 8 * c) = o; }
    asm volatile("s_waitcnt lgkmcnt(0)" ::: "memory");
}

__device__ __forceinline__ void prologue(const Args& A, LAS unsigned char* lds) {
    int tid_l = threadIdx.x; asm volatile("" : "+v"(tid_l));
    const int tid = tid_l, lane = tid & 63, wave = tid >> 6;
    LAS float* scr = (LAS float*)(lds + wave * 19712);
    const int gw = blockIdx.x * 8 + wave, NGW = gridDim.x * 8;
    constexpr int I_IN = 16 * 48, I_OUT = 16 * 16, I_G = 16 * 44, I_DN = 44 * 16, I_PG = 16 * 16, I_PPI = 4 * 16;
    constexpr int PER_L = I_IN + I_OUT + 2 * I_G + I_DN + I_PG + I_PPI;
    for (int it = gw; it < DEPTH * PER_L; it += NGW) {
        const int L = it / PER_L; int r = it % PER_L;
        unsigned char* wl = A.ws + WS_W + (size_t)L * W_LAYER;
        if (r < I_IN) { transpose_item(A.in[I_WIN] + (size_t)L * DM * NIN, DM, NIN, (bf16_t*)(wl + WO_IN), 0, A.in[I_GMIX] + L * DM, A.in[I_GMIX] + L * DM, DM, 512, scr, r, lane); continue; } r -= I_IN;
        if (r < I_OUT) { transpose_item(A.in[I_WOUT] + (size_t)L * DM * DM, DM, DM, (bf16_t*)(wl + WO_OUT), 0, A.in[I_GATT] + L * 512, A.in[I_GCONV] + L * 512, 512, 0, scr, r, lane); continue; } r -= I_OUT;
        if (r < I_G) { transpose_item(A.in[I_WGATE] + (size_t)L * DM * DFF, DM, DFF, (bf16_t*)(wl + WO_GU), 1, A.in[I_GFFN] + L * DM, A.in[I_GFFN] + L * DM, DM, 0, scr, r, lane); continue; } r -= I_G;
        if (r < I_G) { transpose_item(A.in[I_WUP] + (size_t)L * DM * DFF, DM, DFF, (bf16_t*)(wl + WO_GU), 2, A.in[I_GFFN] + L * DM, A.in[I_GFFN] + L * DM, DM, 0, scr, r, lane); continue; } r -= I_G;
        if (r < I_DN) { transpose_item(A.in[I_WDOWN] + (size_t)L * DFF * DM, DFF, DM, (bf16_t*)(wl + WO_DOWN), 0, nullptr, nullptr, 0, 0, scr, r, lane); continue; } r -= I_DN;
        if (r < I_PG) { transpose_item(A.in[I_WPG] + (size_t)L * DM * DM, DM, DM, (bf16_t*)(wl + WO_PG), 0, A.in[I_GPLE] + L * DM, A.in[I_GPLE] + L * DM, DM, 0, scr, r, lane); continue; } r -= I_PG;
        transpose_item(A.in[I_WPP] + (size_t)L * PLE * DM, PLE, DM, (bf16_t*)(wl + WO_PP), 0, nullptr, nullptr, 0, 0, scr, r, lane);
    }
    const float* x = A.in[I_X]; bf16_t* hb = (bf16_t*)(A.ws + WS_HB); float* part = (float*)(A.ws + WS_PART0);
    for (int m = gw; m < MTOK; m += 2 * NGW) {
        const int m2 = m + NGW; const bool has2 = m2 < MTOK;
        const f32x4* xr = (const f32x4*)(x + (size_t)m * DM) + lane; const f32x4* xr2 = (const f32x4*)(x + (size_t)(has2 ? m2 : m) * DM) + lane;
        f32x4 v[4], w[4];
#pragma unroll
        for (int j = 0; j < 4; ++j) { v[j] = xr[64 * j]; w[j] = xr2[64 * j]; }
        float s = 0.f, s2 = 0.f;
        unsigned long long* o8 = (unsigned long long*)(hb + (size_t)m * DM) + lane; unsigned long long* o82 = (unsigned long long*)(hb + (size_t)(has2 ? m2 : m) * DM) + lane;
#pragma unroll
        for (int j = 0; j < 4; ++j) { s += (v[j][0] * v[j][0] + v[j][1] * v[j][1]) + (v[j][2] * v[j][2] + v[j][3] * v[j][3]); s2 += (w[j][0] * w[j][0] + w[j][1] * w[j][1]) + (w[j][2] * w[j][2] + w[j][3] * w[j][3]);
            o8[64 * j] = (unsigned long long)pg8::cvt_pk_bf16(v[j][0], v[j][1]) | ((unsigned long long)pg8::cvt_pk_bf16(v[j][2], v[j][3]) << 32);
            if (has2) o82[64 * j] = (unsigned long long)pg8::cvt_pk_bf16(w[j][0], w[j][1]) | ((unsigned long long)pg8::cvt_pk_bf16(w[j][2], w[j][3]) << 32); }
#pragma unroll
        for (int o = 1; o < 64; o <<= 1) { s += __shfl_xor(s, o); s2 += __shfl_xor(s2, o); }
        if (lane < 16) { part[(size_t)m * 16 + lane] = (lane == 0) ? s : 0.f; if (has2) part[(size_t)m2 * 16 + lane] = (lane == 0) ? s2 : 0.f; }
    }
    const float* p = A.in[I_P]; bf16_t* pb = (bf16_t*)(A.ws + WS_PB);
    const size_t n8 = (size_t)DEPTH * MTOK * PLE / 8, stride = (size_t)gridDim.x * 512;
    for (size_t i = (size_t)blockIdx.x * 512 + tid; i < n8; i += stride) {
        const f32x4 a = *(const f32x4*)(p + i * 8), b = *(const f32x4*)(p + i * 8 + 4);
        u32x4 w; w.x = pg8::cvt_pk_bf16(a[0], a[1]); w.y = pg8::cvt_pk_bf16(a[2], a[3]); w.z = pg8::cvt_pk_bf16(b[0], b[1]); w.w = pg8::cvt_pk_bf16(b[2], b[3]);
        *(u32x4*)(pb + i * 8) = w;
    }
}

__device__ __forceinline__ void unpack8(const u32x4 w, float* f) { f[0] = bf_lo(w.x); f[1] = bf_hi(w.x); f[2] = bf_lo(w.y); f[3] = bf_hi(w.y); f[4] = bf_lo(w.z); f[5] = bf_hi(w.z); f[6] = bf_lo(w.w); f[7] = bf_hi(w.w); }
typedef short v4i16_t __attribute__((ext_vector_type(4)));
constexpr int VS = 144;
constexpr int WREG = 19712;
constexpr int BT_OFF = 9216 + 256, Q_OFF = BT_OFF + 2048;
static_assert(8 * WREG + 2048 <= 163840, "mixer LDS map");
constexpr int SSBUF_OFF = 8 * WREG;
__device__ __forceinline__ v4i16_t vtr(LAS unsigned char* p) { return __builtin_amdgcn_ds_read_tr16_b64_v4i16((LAS v4i16_t*)p); }
__device__ __forceinline__ bf16x8 cat8(v4i16_t a, v4i16_t b) { bf16x8 r; r[0] = a[0]; r[1] = a[1]; r[2] = a[2]; r[3] = a[3]; r[4] = b[0]; r[5] = b[1]; r[6] = b[2]; r[7] = b[3]; return r; }
__device__ __forceinline__ bf16x8 packp(const f32x4 a, const f32x4 b) { u32x4 w; w.x = pg8::cvt_pk_bf16(a[0], a[1]); w.y = pg8::cvt_pk_bf16(a[2], a[3]); w.z = pg8::cvt_pk_bf16(b[0], b[1]); w.w = pg8::cvt_pk_bf16(b[2], b[3]); return __builtin_bit_cast(bf16x8, w); }

template <int JQ> struct QTiles { static constexpr int T0 = (JQ == 0) ? 0 : (JQ == 1) ? 0 : (JQ == 2) ? 1 : 2, T1 = (JQ == 0) ? 1 : (JQ == 1) ? 2 : 3, NT = T1 - T0 + 1; };
template <int JQ> __device__ __forceinline__ void qk(const bf16x8 (&kf)[4][2], LAS const unsigned char* qlds, LAS const float* brow, f32x4 (&s)[3], float (&bb)[3][4]) {
    constexpr int T0 = QTiles<JQ>::T0, NT = QTiles<JQ>::NT;
    const bf16x8 qf[2] = {*(LAS const bf16x8*)(qlds + (2 * JQ) * 1024), *(LAS const bf16x8*)(qlds + (2 * JQ + 1) * 1024)};
#pragma unroll
    for (int t = 0; t < NT; ++t)
#pragma unroll
        for (int e = 0; e < 4; ++e) bb[t][e] = brow[16 * (T0 + t - JQ + 1) + e];
    __builtin_amdgcn_s_setprio(1);
#pragma unroll
    for (int t = 0; t < NT; ++t) {
        f32x4 a = {0.f, 0.f, 0.f, 0.f};
        a = __builtin_amdgcn_mfma_f32_16x16x32_bf16(kf[T0 + t][0], qf[0], a, 0, 0, 0);
        a = __builtin_amdgcn_mfma_f32_16x16x32_bf16(kf[T0 + t][1], qf[1], a, 0, 0, 0);
        s[t] = a;
    }
    __builtin_amdgcn_s_setprio(0);
}
template <int JQ> __device__ __forceinline__ void sm(f32x4 (&s)[3], float (&bb)[3][4], int m0, float& mrun, float& lrun, f32x4 (&o)[4], bf16x8& pA, bf16x8& pB) {
    constexpr int T0 = QTiles<JQ>::T0, NT = QTiles<JQ>::NT;
    const float NEG = -__builtin_inff();
    if (NT == 2) asm volatile("" : "+v"(bb[0][0]), "+v"(bb[0][1]), "+v"(bb[0][2]), "+v"(bb[0][3]), "+v"(bb[1][0]), "+v"(bb[1][1]), "+v"(bb[1][2]), "+v"(bb[1][3]));
    else asm volatile("" : "+v"(bb[0][0]), "+v"(bb[0][1]), "+v"(bb[0][2]), "+v"(bb[0][3]), "+v"(bb[1][0]), "+v"(bb[1][1]), "+v"(bb[1][2]), "+v"(bb[1][3]), "+v"(bb[2][0]), "+v"(bb[2][1]), "+v"(bb[2][2]), "+v"(bb[2][3]));
    float mx = NEG;
#pragma unroll
    for (int t = 0; t < NT; ++t)
#pragma unroll
        for (int e = 0; e < 4; ++e) { const bool valid = (unsigned)(m0 + 16 * (T0 + t) + e) < 16u; const float v = s[t][e] + bb[t][e]; s[t][e] = valid ? v : NEG; mx = fmaxf(mx, s[t][e]); }
    mx = xrow16_max(mx);
    const float mnew = fmaxf(mrun, mx), alpha = __builtin_amdgcn_exp2f(mrun - mnew);
    mrun = mnew;
    float ps = 0.f;
#pragma unroll
    for (int t = 0; t < NT; ++t)
#pragma unroll
        for (int e = 0; e < 4; ++e) { const float p = __builtin_amdgcn_exp2f(s[t][e] - mnew); s[t][e] = p; ps += p; }
    lrun = lrun * alpha + ps;
#pragma unroll
    for (int dt = 0; dt < 4; ++dt) o[dt] *= alpha;
    const f32x4 zz = {0.f, 0.f, 0.f, 0.f};
    if (JQ == 0) { pA = packp(s[0], s[1]); }
    else if (JQ == 1) { pA = packp(s[0], s[1]); pB = packp(s[2], zz); }
    else if (JQ == 2) { pA = packp(zz, s[0]); pB = packp(s[1], s[2]); }
    else { pB = packp(s[0], s[1]); }
}

__device__ __forceinline__ void mixer_attn(const bf16_t* Z, bf16_t* MIX, int b, int r, LAS unsigned char* lds) {
    int tid_l = threadIdx.x; asm volatile("" : "+v"(tid_l));
    const int tid = tid_l, lane = tid & 63, h = __builtin_amdgcn_readfirstlane(tid >> 6), i = lane & 15, g = lane >> 4;
    LAS unsigned char* wl = lds + h * WREG;
    LAS const float* btab = (LAS const float*)(wl + BT_OFF);
    LAS float* ssbuf = (LAS float*)(lds + SSBUF_OFF);
    const bf16_t* zq = Z + ((size_t)b * SEQ + r * 64) * NIN + h * 64;
    LAS unsigned char* qlds = wl + Q_OFF + lane * 16;
#pragma unroll
    for (int jq = 0; jq < 4; ++jq)
#pragma unroll
        for (int dh = 0; dh < 2; ++dh) *(LAS bf16x8*)(qlds + (2 * jq + dh) * 1024) = *(const bf16x8*)((const char*)zq + (size_t)(((16 * jq) * NIN + 32 * dh) * 2) + (unsigned)(i * NIN + 8 * g) * 2u);
    f32x4 o[4][4]; float mrun[4], lrun[4]; int m0[4];
#pragma unroll
    for (int jq = 0; jq < 4; ++jq) { mrun[jq] = -__builtin_inff(); lrun[jq] = 0.f; m0[jq] = 4 * g - min(max(16 * jq + i - 8, 0), 48);
#pragma unroll
        for (int dt = 0; dt < 4; ++dt) o[jq][dt] = (f32x4){0.f, 0.f, 0.f, 0.f}; }
    const int r0 = min(max(r - 4, 0), 56), c0 = 4 * g - i;
    LAS unsigned char* vrd = wl + (4 * g + (i >> 2)) * VS + 8 * (i & 3);
    const bf16_t* kbb = Z + ((size_t)b * SEQ) * NIN + h * 64;
    const bf16_t* kb0 = kbb + (size_t)((r0 + ((0 - r0) & 7)) * 64) * NIN;
    const unsigned kfo = (unsigned)(i * NIN + 8 * g) * 2u;
    const unsigned vfo = (unsigned)((lane >> 3) * NIN + 8 * (lane & 7)) * 2u;
#define LDK(rowp, kt, dh) (*(const bf16x8*)((const char*)(rowp) + (size_t)(((16 * (kt)) * NIN + 512 + 32 * (dh)) * 2) + kfo))
#define LDV(rowp, n) (*(const u32x4*)((const char*)(rowp) + (size_t)(((8 * (n)) * NIN + 1024) * 2) + vfo))
    bf16x8 kf[4][2]; u32x4 vc[8];
#pragma unroll
    for (int n = 0; n < 8; ++n) vc[n] = LDV(kb0, n);
    asm volatile("" ::: "memory");
#pragma unroll
    for (int kt = 0; kt < 4; ++kt)
#pragma unroll
        for (int dh = 0; dh < 2; ++dh) kf[kt][dh] = LDK(kb0, kt, dh);
    asm volatile("" ::: "memory");
#pragma unroll 1
    for (int kr = 0; kr < 8; ++kr) {
        const int krow = r0 + ((kr - r0) & 7);
        const bf16_t* kbn = kbb + (size_t)((r0 + ((min(kr + 1, 7) - r0) & 7)) * 64) * NIN;
#pragma unroll
        for (int n = 0; n < 8; ++n) { const int ch = lane + 64 * n; *(LAS u32x4*)(wl + (ch >> 3) * VS + 16 * (ch & 7)) = vc[n]; }
        asm volatile("" ::: "memory");
#pragma unroll
        for (int n = 0; n < 8; ++n) vc[n] = LDV(kbn, n);
        asm volatile("" ::: "memory");
        LAS const float* brow = btab + (krow - r + 7) * 31 - 1 + c0;
        bf16x8 pf[6];
        bf16x8 dummy;
        f32x4 sA[3], sB[3]; float bA[3][4], bB[3][4];
        qk<0>(kf, qlds, brow, sA, bA);
        qk<1>(kf, qlds, brow, sB, bB);
        sm<0>(sA, bA, m0[0], mrun[0], lrun[0], o[0], pf[0], dummy);
        qk<2>(kf, qlds, brow, sA, bA);
        sm<1>(sB, bB, m0[1], mrun[1], lrun[1], o[1], pf[1], pf[2]);
        qk<3>(kf, qlds, brow, sB, bB);
        asm volatile("" ::: "memory");
#pragma unroll
        for (int kt = 0; kt < 4; ++kt)
#pragma unroll
            for (int dh = 0; dh < 2; ++dh) kf[kt][dh] = LDK(kbn, kt, dh);
        asm volatile("" ::: "memory");
        sm<2>(sA, bA, m0[2], mrun[2], lrun[2], o[2], pf[3], pf[4]);
        sm<3>(sB, bB, m0[3], mrun[3], lrun[3], o[3], dummy, pf[5]);
        __builtin_amdgcn_s_setprio(1);
#pragma unroll
        for (int dt = 0; dt < 4; ++dt) {
            const bf16x8 a01 = cat8(vtr(vrd + 32 * dt), vtr(vrd + 16 * VS + 32 * dt)), a23 = cat8(vtr(vrd + 32 * VS + 32 * dt), vtr(vrd + 48 * VS + 32 * dt));
            o[0][dt] = __builtin_amdgcn_mfma_f32_16x16x32_bf16(a01, pf[0], o[0][dt], 0, 0, 0);
            o[1][dt] = __builtin_amdgcn_mfma_f32_16x16x32_bf16(a01, pf[1], o[1][dt], 0, 0, 0);
            o[1][dt] = __builtin_amdgcn_mfma_f32_16x16x32_bf16(a23, pf[2], o[1][dt], 0, 0, 0);
            o[2][dt] = __builtin_amdgcn_mfma_f32_16x16x32_bf16(a01, pf[3], o[2][dt], 0, 0, 0);
            o[2][dt] = __builtin_amdgcn_mfma_f32_16x16x32_bf16(a23, pf[4], o[2][dt], 0, 0, 0);
            o[3][dt] = __builtin_amdgcn_mfma_f32_16x16x32_bf16(a23, pf[5], o[3][dt], 0, 0, 0);
        }
        __builtin_amdgcn_s_setprio(0);
    }
#pragma unroll
    for (int jq = 0; jq < 4; ++jq) {
        const float lt = xrow16_sum(lrun[jq]);
        const float inv = 1.0f / lt; float ss = 0.f;
#pragma unroll
        for (int dt = 0; dt < 4; ++dt) { o[jq][dt] *= inv; ss += (o[jq][dt][0] * o[jq][dt][0] + o[jq][dt][1] * o[jq][dt][1]) + (o[jq][dt][2] * o[jq][dt][2] + o[jq][dt][3] * o[jq][dt][3]); }
        ss = xrow16_sum(ss);
        if (g == 0) ssbuf[h * 64 + 16 * jq + i] = ss;
    }
    __syncthreads();
    bf16_t* mo = MIX + ((size_t)b * SEQ + r * 64) * DM + h * 64 + 4 * g;
#pragma unroll
    for (int jq = 0; jq < 4; ++jq) {
        float tot = 0.f;
#pragma unroll
        for (int hh = 0; hh < 8; ++hh) tot += ssbuf[hh * 64 + 16 * jq + i];
        const float rinv = __builtin_amdgcn_rsqf(tot * (1.0f / 512.0f) + EPS);
#pragma unroll
        for (int dt = 0; dt < 4; ++dt) { const f32x4 v = o[jq][dt] * rinv;
            *(unsigned long long*)(mo + (size_t)(16 * jq + i) * DM + 16 * dt) = (unsigned long long)pg8::cvt_pk_bf16(v[0], v[1]) | ((unsigned long long)pg8::cvt_pk_bf16(v[2], v[3]) << 32); }
    }
    __syncthreads();
}

#undef LDK
#undef LDV
__device__ __forceinline__ void mixer_conv(const bf16_t* Z, bf16_t* MIX, const float* convw, int b, int r) {
    int tid_l = threadIdx.x; asm volatile("" : "+v"(tid_l));
    const int tid = tid_l, lane = tid & 63, wave = tid >> 6, ch = 8 * lane;
    float w[3][8];
#pragma unroll
    for (int k = 0; k < 3; ++k) { const f32x4 a = *(const f32x4*)(convw + k * 512 + ch), c = *(const f32x4*)(convw + k * 512 + ch + 4);
#pragma unroll
        for (int e = 0; e < 4; ++e) { w[k][e] = a[e]; w[k][4 + e] = c[e]; } }
#pragma unroll 1
    for (int half = 0; half < 2; ++half) {
        const int s0 = r * 64 + wave * 8 + half * 4;
        const bf16_t* base = Z + ((size_t)b * SEQ + s0) * NIN + ch;
        const u32x4 z4 = {0u, 0u, 0u, 0u};
        u32x4 ccw[6], cuw[6], cbw[4];
#pragma unroll
        for (int j = 0; j < 6; ++j) { const int s = s0 - 1 + j; const bool in = (s >= 0) && (s < SEQ); const bf16_t* p = base + (ptrdiff_t)(j - 1) * NIN;
            ccw[j] = in ? *(const u32x4*)(p + 2048) : z4; cuw[j] = in ? *(const u32x4*)(p + 2560) : z4; }
#pragma unroll
        for (int j = 0; j < 4; ++j) cbw[j] = *(const u32x4*)(base + (size_t)j * NIN + 1536);
        float u[6][8];
#pragma unroll
        for (int j = 0; j < 6; ++j) { float c8[8], u8[8]; unpack8(ccw[j], c8); unpack8(cuw[j], u8);
#pragma unroll
            for (int e = 0; e < 8; ++e) u[j][e] = c8[e] * u8[e]; }
        float cv[4][8], ss[4];
#pragma unroll
        for (int j = 0; j < 4; ++j) { float cb[8]; unpack8(cbw[j], cb); ss[j] = 0.f;
#pragma unroll
            for (int e = 0; e < 8; ++e) { cv[j][e] = cb[e] * (w[0][e] * u[j][e] + w[1][e] * u[j + 1][e] + w[2][e] * u[j + 2][e]); ss[j] += cv[j][e] * cv[j][e]; } }
#pragma unroll
        for (int o = 1; o < 64; o <<= 1)
#pragma unroll
            for (int j = 0; j < 4; ++j) ss[j] += __shfl_xor(ss[j], o);
#pragma unroll
        for (int j = 0; j < 4; ++j) { const float rinv = __builtin_amdgcn_rsqf(ss[j] * (1.0f / 512.0f) + EPS);
            u32x4 o; o.x = pg8::cvt_pk_bf16(cv[j][0] * rinv, cv[j][1] * rinv); o.y = pg8::cvt_pk_bf16(cv[j][2] * rinv, cv[j][3] * rinv); o.z = pg8::cvt_pk_bf16(cv[j][4] * rinv, cv[j][5] * rinv); o.w = pg8::cvt_pk_bf16(cv[j][6] * rinv, cv[j][7] * rinv);
            *(u32x4*)(MIX + ((size_t)b * SEQ + s0 + j) * DM + 512 + ch) = o; }
    }
}

__device__ __forceinline__ void mixer_phase(const bf16_t* Z, bf16_t* MIX, const float* rpb, const float* convw, int u0, int u1, int ustep, LAS unsigned char* lds) {
    int tid_l = threadIdx.x; asm volatile("" : "+v"(tid_l));
    const int tid = tid_l, lane = tid & 63, h = tid >> 6;
    LAS float* btab = (LAS float*)(lds + h * WREG + BT_OFF);
    for (int e = lane; e < 15 * 31; e += 64) btab[e] = rpb[h * 15 * 31 + e] * 1.44269504088896f;
    __syncthreads();
    for (int u = u0; u < u1; u += ustep) { mixer_attn(Z, MIX, u >> 6, u & 63, lds); mixer_conv(Z, MIX, convw, u >> 6, u & 63); }
}

__device__ __forceinline__ void group_barrier(unsigned* ctr, unsigned& gen) {
    asm volatile("s_waitcnt vmcnt(0)" ::: "memory");
    __syncthreads();
    gen += 32u;
    int tid_l = threadIdx.x; asm volatile("" : "+v"(tid_l));
    if (tid_l == 0) {
        __builtin_amdgcn_fence(__ATOMIC_RELEASE, "agent");
        asm volatile("s_waitcnt vmcnt(0)" ::: "memory");
        __hip_atomic_fetch_add(ctr, 1u, __ATOMIC_RELAXED, __HIP_MEMORY_SCOPE_AGENT);
        while (__hip_atomic_load(ctr, __ATOMIC_RELAXED, __HIP_MEMORY_SCOPE_AGENT) < gen) __builtin_amdgcn_s_sleep(2);
        __builtin_amdgcn_fence(__ATOMIC_ACQUIRE, "agent");
        asm volatile("s_waitcnt vmcnt(0)" ::: "memory");
    }
    __syncthreads();
}
__device__ __forceinline__ void group_arrive(unsigned* ctr, unsigned& gen) {
    asm volatile("s_waitcnt vmcnt(0)" ::: "memory");
    __syncthreads();
    gen += 32u;
    int tid_l = threadIdx.x; asm volatile("" : "+v"(tid_l));
    if (tid_l == 0) {
        __builtin_amdgcn_fence(__ATOMIC_RELEASE, "agent");
        asm volatile("s_waitcnt vmcnt(0)" ::: "memory");
        __hip_atomic_fetch_add(ctr, 1u, __ATOMIC_RELAXED, __HIP_MEMORY_SCOPE_AGENT);
    }
}
__device__ __forceinline__ void group_wait(unsigned* ctr, unsigned gen) {
    int tid_l = threadIdx.x; asm volatile("" : "+v"(tid_l));
    if (tid_l == 0) {
        while (__hip_atomic_load(ctr, __ATOMIC_RELAXED, __HIP_MEMORY_SCOPE_AGENT) < gen) __builtin_amdgcn_s_sleep(2);
        __builtin_amdgcn_fence(__ATOMIC_ACQUIRE, "agent");
        asm volatile("s_waitcnt vmcnt(0)" ::: "memory");
    }
    __syncthreads();
}
__global__ void __launch_bounds__(512, 2) mega(Args A) {
    extern __shared__ __attribute__((aligned(16))) unsigned char lds_raw[];
    LAS unsigned char* lds = (LAS unsigned char*)lds_raw;
    cg::grid_group grid = cg::this_grid();
    const int G = gridDim.x, bx = blockIdx.x;
    const int vcu = (G % 8 == 0) ? (bx % 8) * (G / 8) + bx / 8 : bx;
    unsigned char* ws = A.ws;
    float* part[2] = {(float*)(ws + WS_PART0), (float*)(ws + WS_PART1)};
    bf16_t* const HB0 = (bf16_t*)(ws + WS_HB); bf16_t* const HB1 = (bf16_t*)(ws + WS_HB1);
    bf16_t* Z = (bf16_t*)(ws + WS_Z); bf16_t* ACT = Z; bf16_t* MIX = (bf16_t*)(ws + WS_MIX); bf16_t* PP = MIX;

    if (bx == 0 && threadIdx.x < 8) __hip_atomic_store((unsigned*)(ws + WS_BAR) + 64 * threadIdx.x, 0u, __ATOMIC_RELAXED, __HIP_MEMORY_SCOPE_AGENT);
#ifndef NO_P0
    prologue(A, lds);
#endif
    grid.sync();
    const bool grouped = (G == 256);
    unsigned* const gctr = (unsigned*)(ws + WS_BAR) + 64 * (bx & 7); unsigned ggen = 0u;
#define SEAM() do { if (grouped) group_barrier(gctr, ggen); else grid.sync(); } while (0)

    int np = 0;
    for (int L = 0; L < DEPTH; ++L) {
        unsigned char* wl = ws + WS_W + (size_t)L * W_LAYER;
        bf16_t* HB = (L & 1) ? HB1 : HB0; bf16_t* HBn = (L & 1) ? HB0 : HB1;
        {
            pg8::Gemm g{HB, (const bf16_t*)(wl + WO_IN), MTOK, NIN, DM, DM}; pg8::StaticOrder S; S.init(MTOK, NIN, G, bx);
            Epi<0> E{Z, NIN, part[np & 1], nullptr, nullptr, nullptr};
#ifndef NO_G1
            pg8::gemm_phase<Epi<0>, pg8::StaticOrder, true, true>(lds, g, S, E);
#endif
        }
        SEAM();
        {
            const float* rpb = A.in[I_RPB] + (size_t)L * 8 * 15 * 31; const float* cw = A.in[I_CONVW] + (size_t)L * 3 * 512;
#ifndef NO_MIX
            mixer_phase(Z, MIX, rpb, cw, grouped ? 128 * (bx & 7) + (bx >> 3) : bx, grouped ? 128 * (bx & 7) + 128 : 1024, grouped ? 32 : G, lds);
#endif
        }
        SEAM();
        {
            pg8::Gemm g{MIX, (const bf16_t*)(wl + WO_OUT), MTOK, DM, DM, DM}; pg8::StaticOrder S; S.init(MTOK, DM, G, bx);
            Epi<3> E{HB, DM, nullptr, HB, part[(np + 1) & 1], nullptr};
#ifndef NO_G2
            pg8::gemm_phase<Epi<3>, pg8::StaticOrder, true, true>(lds, g, S, E);
#endif
            ++np;
        }
        SEAM();
        {
            pg8::Gemm g{HB, (const bf16_t*)(wl + WO_GU), MTOK, NGU, DM, DM}; pg8::StaticOrder S; S.init(MTOK, NGU, G, bx);
            Epi<1> E{ACT, NIN, part[np & 1], nullptr, nullptr, nullptr};
#ifndef NO_G3
            pg8::gemm_phase<Epi<1>, pg8::StaticOrder, true, true>(lds, g, S, E);
#endif
        }
        if (grouped) group_arrive(gctr, ggen); else grid.sync();
        {
            pg8::Gemm g{(const bf16_t*)(ws + WS_PB) + (size_t)L * MTOK * PLE, (const bf16_t*)(wl + WO_PP), MTOK, DM, PLE, PLE}; pg8::StaticOrder S; S.init(MTOK, DM, G, bx);
            Epi<2> E{PP, DM, nullptr, nullptr, nullptr, nullptr};
#ifndef NO_G5
            pg8::gemm_phase<Epi<2>, pg8::StaticOrder, true, true>(lds, g, S, E);
#endif
        }
        if (grouped) group_wait(gctr, ggen);
        {
            pg8::Gemm g{ACT, (const bf16_t*)(wl + WO_DOWN), MTOK, DM, DFF, NIN}; pg8::StaticOrder S; S.init(MTOK, DM, G, bx);
            Epi<3> E{HB, DM, nullptr, HB, part[(np + 1) & 1], nullptr};
#ifndef NO_G4
            pg8::gemm_phase<Epi<3>, pg8::StaticOrder, true, true>(lds, g, S, E);
#endif
            ++np;
        }
        SEAM();
        {
            pg8::Gemm g{HB, (const bf16_t*)(wl + WO_PG), MTOK, DM, DM, DM}; pg8::StaticOrder S; S.init(MTOK, DM, G, bx);
            Epi<4> E{HBn, DM, part[np & 1], HB, part[(np + 1) & 1], PP};
#ifndef NO_G6
            pg8::gemm_phase<Epi<4>, pg8::StaticOrder, true, true>(lds, g, S, E);
#endif
            ++np;
        }
        SEAM();
    }
    if (!grouped) grid.sync();
    {
        static_assert(DEPTH % 2 == 0, "the final residual stream must end in the d_ws copy");
        int tid_l = threadIdx.x; asm volatile("" : "+v"(tid_l));
        const int lane = tid_l & 63, wave = tid_l >> 6; const float* gf = A.in[I_GFINAL]; const float* pr = part[np & 1];
        f32x4 gv[4];
#pragma unroll
        for (int j = 0; j < 4; ++j) gv[j] = *((const f32x4*)gf + lane + 64 * j);
        const int m0 = grouped ? 8192 * (bx & 7) + (bx >> 3) * 8 + wave : bx * 8 + wave, m1 = grouped ? 8192 * (bx & 7) + 8192 : MTOK, ms = grouped ? 256 : G * 8;
        for (int m = m0; m < m1; m += 4 * ms) {
            float rinv[4]; unsigned long long w[4][4];
#pragma unroll
            for (int q = 0; q < 4; ++q) { const int mq = (m + q * ms < m1) ? m + q * ms : m; rinv[q] = row_rinv(pr, mq);
                const unsigned long long* hr = (const unsigned long long*)(HB0 + (size_t)mq * DM) + lane;
#pragma unroll
                for (int j = 0; j < 4; ++j) w[q][j] = hr[64 * j]; }
#pragma unroll
            for (int q = 0; q < 4; ++q) if (m + q * ms < m1) { f32x4* orow = (f32x4*)(A.out + (size_t)(m + q * ms) * DM) + lane;
#pragma unroll
                for (int j = 0; j < 4; ++j) { const unsigned lo = (unsigned)w[q][j], hi = (unsigned)(w[q][j] >> 32);
                    const f32x4 v = {bf_lo(lo), bf_hi(lo), bf_lo(hi), bf_hi(hi)}; orow[64 * j] = v * rinv[q] * gv[j]; } }
        }
    }
}

extern "C" void kernel_launch(void* const* d_in, const int* in_sizes, int n_in, void* d_out, int out_size, void* d_ws, size_t ws_size, hipStream_t stream) {
    static int grid = 0;
    if (grid == 0) {
        if (n_in != 17 || out_size != MTOK * DM || ws_size < WS_END) { fprintf(stderr, "kernel_launch: unexpected shapes (n_in %d out %d ws %zu)\n", n_in, out_size, ws_size); grid = -1; return; }
        int dev = 0, cus = 0, per_cu = 0;
        hipGetDevice(&dev); hipDeviceGetAttribute(&cus, hipDeviceAttributeMultiprocessorCount, dev);
        hipFuncSetAttribute((const void*)mega, hipFuncAttributeMaxDynamicSharedMemorySize, LDS_BYTES);
        hipOccupancyMaxActiveBlocksPerMultiprocessor(&per_cu, (const void*)mega, 512, LDS_BYTES);
        if (per_cu < 1) { fprintf(stderr, "kernel_launch: occupancy query says %d blocks per CU\n", per_cu); per_cu = 1; }
        (void)hipGetLastError();
        grid = cus * per_cu;
    }
    if (grid < 0) return;
    Args a{};
    for (int i = 0; i < 17; ++i) a.in[i] = (const float*)d_in[i];
    a.out = (float*)d_out; a.ws = (unsigned char*)d_ws;
    void* args[] = {&a};
    hipError_t e = hipLaunchCooperativeKernel((const void*)mega, dim3(grid), dim3(512), args, LDS_BYTES, stream);
    if (e != hipSuccess) fprintf(stderr, "cooperative launch failed: %s (grid %d)\n", hipGetErrorString(e), grid);
}
```
